# Optimizing an MI355X kernel written in HIP

```python
import math
import jax, jax.numpy as jnp
from jax import lax
import numpy as np

D_MODEL = 2048
BATCH = 8
SEQ = 4096
DEPTH = 4

N_MEM = 256
HEAD_DIM = 128
MIX_WIDTH = D_MODEL
MEM_HEADS = 4
MEM_WIDTH = MEM_HEADS * HEAD_DIM
LOCAL_WIDTH = MIX_WIDTH - MEM_WIDTH
POOL_WINDOWS = (2, 4, 8, 16)
POOL_GROUP = LOCAL_WIDTH // len(POOL_WINDOWS)
DIL_PATTERNS = ((128, 1), (512, 4), (2048, 16))
DIL_HEADS_PER_GROUP = LOCAL_WIDTH // HEAD_DIM // len(DIL_PATTERNS)
DIL_GROUP_WIDTH = DIL_HEADS_PER_GROUP * HEAD_DIM
Q_BLOCK = 128
N_MIXERS = 2
N_POOL_LAYERS = (DEPTH + 1) // 2
N_DIL_LAYERS = DEPTH // 2
PEER_HEADS = 8
PEER_N_KEYS = 128
PEER_EXPERTS = PEER_N_KEYS * PEER_N_KEYS
PEER_TOPK = 16
PEER_QDIM = 256
PEER_HALF = PEER_QDIM // 2
PEER_CHUNK = 128
DEEPNORM_ALPHA = (2 * DEPTH) ** 0.25
DEEPNORM_BETA = (8 * DEPTH) ** -0.25
LN_EPS = 1e-5
NEG = -1e30

kernel_name = "hybrid_pool_dilated_peer_deepnorm"


def layer_norm(z, g, b):
    zf = z.astype(jnp.float32)
    mu = jnp.mean(zf, axis=-1, keepdims=True)
    var = jnp.mean(jnp.square(zf - mu), axis=-1, keepdims=True)
    return ((zf - mu) * lax.rsqrt(var + LN_EPS) * g.astype(jnp.float32)
            + b.astype(jnp.float32)).astype(z.dtype)


def pool_mixer(p, w_pool, s_pool):
    B, S, _ = p.shape
    pf = p.astype(jnp.float32)
    csum = jnp.cumsum(pf, axis=1)
    t = jnp.arange(S)
    outs = []
    for g, w in enumerate(POOL_WINDOWS):
        sl = slice(g * POOL_GROUP, (g + 1) * POOL_GROUP)
        cg = csum[..., sl]
        lower = jnp.pad(cg[:, :S - w], ((0, 0), (w, 0), (0, 0)))
        cnt = jnp.minimum(t + 1, w).astype(jnp.float32)[None, :, None]
        diff = ((cg - lower) / cnt - pf[..., sl]).astype(p.dtype)
        outs.append(diff @ w_pool[g])
    return jnp.concatenate(outs, axis=-1) * s_pool


def dilated_attention(q, k, v):
    B, S, _ = q.shape
    nb = S // Q_BLOCK
    starts = jnp.arange(nb) * Q_BLOCK
    scale = HEAD_DIM ** -0.5
    outs, lses = [], []
    for g, (window, dil) in enumerate(DIL_PATTERNS):
        sl = slice(g * DIL_GROUP_WIDTH, (g + 1) * DIL_GROUP_WIDTH)
        qg = q[..., sl].reshape(B, S, DIL_HEADS_PER_GROUP, HEAD_DIM)
        kg = k[..., sl].reshape(B, S, DIL_HEADS_PER_GROUP, HEAD_DIM)
        vg = v[..., sl].reshape(B, S, DIL_HEADS_PER_GROUP, HEAD_DIM)
        offs = dil * jnp.arange(window // dil + 1)

        def block(start, qg=qg, kg=kg, vg=vg, offs=offs):
            t = start + jnp.arange(Q_BLOCK)
            idx = t[:, None] - offs[None, :]
            valid = idx >= 0
            idx = jnp.maximum(idx, 0)
            qb = lax.dynamic_slice_in_dim(qg, start, Q_BLOCK, axis=1)
            kb = jnp.take(kg, idx, axis=1)
            vb = jnp.take(vg, idx, axis=1)
            s = jnp.einsum('bqhd,bqjhd->bhqj', qb, kb).astype(jnp.float32) * scale
            s = jnp.where(valid[None, None], s, NEG)
            lse = jax.nn.logsumexp(s, axis=-1)
            pr = jnp.exp(s - lse[..., None]).astype(vb.dtype)
            o = jnp.einsum('bhqj,bqjhd->bqhd', pr, vb)
            return o, lse

        o, lse = lax.map(block, starts)
        outs.append(o.transpose(1, 0, 2, 3, 4).reshape(B, S, DIL_HEADS_PER_GROUP, HEAD_DIM))
        lses.append(lse.transpose(1, 0, 3, 2).reshape(B, S, DIL_HEADS_PER_GROUP))
    alpha = jax.nn.softmax(jnp.stack(lses, axis=0), axis=0)
    merged = [outs[g] * alpha[g][..., None].astype(outs[g].dtype) for g in range(len(DIL_PATTERNS))]
    return jnp.concatenate(merged, axis=2).reshape(B, S, LOCAL_WIDTH)


def memory_attention(qm, mem, w_kv):
    B, S, _ = qm.shape
    kv = mem @ w_kv
    km = kv[..., :MEM_WIDTH].reshape(B, -1, MEM_HEADS, HEAD_DIM)
    vm = kv[..., MEM_WIDTH:].reshape(B, -1, MEM_HEADS, HEAD_DIM)
    qh = qm.reshape(B, S, MEM_HEADS, HEAD_DIM)
    s = jnp.einsum('bshd,bmhd->bhsm', qh, km).astype(jnp.float32) * (HEAD_DIM ** -0.5)
    pr = jax.nn.softmax(s, axis=-1).astype(vm.dtype)
    return jnp.einsum('bhsm,bmhd->bshd', pr, vm).reshape(B, S, MEM_WIDTH)


def peer_ffn(x, w_q, sub_keys, u, v):
    B, S, D = x.shape
    xt = x.reshape(-1, PEER_CHUNK, D)

    def chunk(xc):
        q = (xc @ w_q).reshape(PEER_CHUNK, PEER_HEADS, 2, PEER_HALF)
        s = jnp.einsum('chpk,hpnk->chpn', q, sub_keys).astype(jnp.float32)
        v1, i1 = lax.top_k(s[:, :, 0], PEER_TOPK)
        v2, i2 = lax.top_k(s[:, :, 1], PEER_TOPK)
        cand = (v1[..., :, None] + v2[..., None, :]).reshape(PEER_CHUNK, PEER_HEADS, PEER_TOPK * PEER_TOPK)
        cidx = (i1[..., :, None] * PEER_N_KEYS + i2[..., None, :]).reshape(PEER_CHUNK, PEER_HEADS, PEER_TOPK * PEER_TOPK)
        sv, sel = lax.top_k(cand, PEER_TOPK)
        eidx = jnp.take_along_axis(cidx, sel, axis=-1)
        gate = jax.nn.softmax(sv, axis=-1)
        u_sel = u[eidx]
        a = jnp.einsum('cd,chkd->chk', xc, u_sel).astype(jnp.float32)
        wgt = (gate * jax.nn.gelu(a, approximate=False)).astype(xc.dtype)
        v_sel = v[eidx]
        return jnp.einsum('chk,chkd->cd', wgt, v_sel)

    return lax.map(chunk, xt).reshape(B, S, D)


def setup_inputs(seed: int = 0) -> dict:
    key = jax.random.key(seed)
    ks = jax.random.split(key, 18)

    def nrm(k, shape, scale):
        return jax.random.normal(k, shape, jnp.float32) * scale

    s_in = D_MODEL ** -0.5
    beta = DEEPNORM_BETA
    x = nrm(ks[0], (BATCH, SEQ, D_MODEL), 1.0)
    mem = nrm(ks[1], (BATCH, N_MEM, D_MODEL), 1.0)
    w_in_a = jnp.concatenate([nrm(ks[2], (N_POOL_LAYERS, D_MODEL, LOCAL_WIDTH), s_in * beta),
                              nrm(ks[3], (N_POOL_LAYERS, D_MODEL, MEM_WIDTH), s_in)], axis=-1)
    w_pool = nrm(ks[4], (N_POOL_LAYERS, len(POOL_WINDOWS), POOL_GROUP, POOL_GROUP), POOL_GROUP ** -0.5)
    s_pool = 1.0 + nrm(ks[5], (N_POOL_LAYERS, LOCAL_WIDTH), 0.1)
    w_in_b = jnp.concatenate([nrm(ks[6], (N_DIL_LAYERS, D_MODEL, 2 * LOCAL_WIDTH), s_in),
                              nrm(ks[7], (N_DIL_LAYERS, D_MODEL, LOCAL_WIDTH), s_in * beta),
                              nrm(ks[8], (N_DIL_LAYERS, D_MODEL, MEM_WIDTH), s_in)], axis=-1)
    w_mem_kv = jnp.concatenate([nrm(ks[9], (DEPTH, D_MODEL, MEM_WIDTH), s_in),
                                nrm(ks[10], (DEPTH, D_MODEL, MEM_WIDTH), s_in * beta)], axis=-1)
    w_o = nrm(ks[11], (DEPTH, MIX_WIDTH, D_MODEL), MIX_WIDTH ** -0.5 * beta)
    ln_g = 1.0 + nrm(ks[12], (DEPTH, 2, D_MODEL), 0.05)
    ln_b = nrm(ks[13], (DEPTH, 2, D_MODEL), 0.02)
    peer_wq = nrm(ks[14], (DEPTH, D_MODEL, PEER_HEADS * PEER_QDIM), s_in)
    peer_keys = nrm(ks[15], (DEPTH, PEER_HEADS, 2, PEER_N_KEYS, PEER_HALF), PEER_HALF ** -0.5)
    peer_u = nrm(ks[16], (DEPTH, PEER_EXPERTS, D_MODEL), s_in)
    peer_v = nrm(ks[17], (DEPTH, PEER_EXPERTS, D_MODEL), beta * PEER_HEADS ** -0.5)
    return {"x": x, "mem": mem, "w_in_a": w_in_a, "w_pool": w_pool, "s_pool": s_pool,
            "w_in_b": w_in_b, "w_mem_kv": w_mem_kv, "w_o": w_o, "ln_g": ln_g, "ln_b": ln_b,
            "peer_wq": peer_wq, "peer_keys": peer_keys, "peer_u": peer_u, "peer_v": peer_v}


def reference(x, mem, w_in_a, w_pool, s_pool, w_in_b, w_mem_kv, w_o, ln_g, ln_b,
              peer_wq, peer_keys, peer_u, peer_v):
    ia = 0
    ib = 0
    for i in range(DEPTH):
        if i % N_MIXERS == 0:
            h = x @ w_in_a[ia]
            local = pool_mixer(h[..., :LOCAL_WIDTH], w_pool[ia], s_pool[ia])
            qm = h[..., LOCAL_WIDTH:]
            ia += 1
        else:
            h = x @ w_in_b[ib]
            q = h[..., :LOCAL_WIDTH]
            k = h[..., LOCAL_WIDTH:2 * LOCAL_WIDTH]
            v = h[..., 2 * LOCAL_WIDTH:3 * LOCAL_WIDTH]
            local = dilated_attention(q, k, v)
            qm = h[..., 3 * LOCAL_WIDTH:]
            ib += 1
        mem_out = memory_attention(qm, mem, w_mem_kv[i])
        mix = jnp.concatenate([local, mem_out], axis=-1) @ w_o[i]
        x = layer_norm(DEEPNORM_ALPHA * x + mix, ln_g[i, 0], ln_b[i, 0])
        ffn = peer_ffn(x, peer_wq[i], peer_keys[i], peer_u[i], peer_v[i])
        x = layer_norm(DEEPNORM_ALPHA * x + ffn, ln_g[i, 1], ln_b[i, 1])
    return x
```

```cpp
#include <hip/hip_runtime.h>
#include <stdint.h>
namespace pg8 {
#define PG8_LAS __attribute__((address_space(3)))
typedef unsigned short bf16_t;
typedef short bf16x8 __attribute__((ext_vector_type(8)));
typedef float f32x4 __attribute__((ext_vector_type(4)));
typedef unsigned u32x4 __attribute__((ext_vector_type(4)));
constexpr int BM = 256, BK = 64, HALF = 128, HTB = HALF * BK * 2  , STAGE_BYTES = 8 * HTB, NXCD = 8, WGM = 8;

__host__ __device__ __forceinline__ int lds_byte(int r, int c) { const int st = (r >> 4) * 2 + (c >> 5), rr = r & 15, cc = c & 31, ob = rr * 64 + cc * 2; return st * 1024 + (ob ^ (((ob >> 9) & 1) << 5)); }
__host__ __device__ __forceinline__ void stage_rc(int b, int& R, int& C) { const int st = b / 1024, sb = b % 1024, swz = sb ^ (((sb >> 9) & 1) << 5); R = (st >> 1) * 16 + swz / 64; C = (st & 1) * 32 + (swz % 64) / 2; }
__host__ __device__ __forceinline__ int perm32(int rho) { const int n = rho >> 4, i = rho & 15; return 8 * (i >> 2) + 4 * n + (i & 3); }

struct Unit { int pm, pn; };
struct Gemm { const bf16_t* A; const bf16_t* Bt; int M, N, K, pad; };

struct StaticOrder {
    int nM, nN, nwg, G, c;
    __host__ __device__ void init(int M, int N, int G_, int c_) { nM = M / BM; nN = N / BM; nwg = nM * nN; G = G_; c = c_; }
    __host__ __device__ bool next(int i, Unit& u) const {
        const long L = (long)i * G + c; if (L >= nwg) return false;
        int wgid = (int)L; { const int q = nwg / NXCD, r = nwg % NXCD, xcd = wgid % NXCD, off = wgid / NXCD; wgid = (xcd < r ? xcd * (q + 1) : r * (q + 1) + (xcd - r) * q) + off; }
        const int nig = WGM * nN, gid = wgid / nig, fm = gid * WGM, gsz = (nM - fm) < WGM ? (nM - fm) : WGM;
        u.pm = fm + ((wgid % nig) % gsz); u.pn = (wgid % nig) / gsz; return true;
    }
    __device__ __forceinline__ void a_ready(const Unit&) const {}
    __device__ __forceinline__ void done(const Unit&) const {}
};

__device__ __forceinline__ unsigned cvt_pk_bf16(float lo, float hi) { unsigned r; asm volatile("v_cvt_pk_bf16_f32 %0, %1, %2" : "=v"(r) : "v"(lo), "v"(hi)); return r; }

template <class Epi, class Sched>
__device__ __forceinline__ void gemm_phase(PG8_LAS unsigned char* lds, const Gemm g, const Sched& S, const Epi& E) {
    const int tid = threadIdx.x, wid = __builtin_amdgcn_readfirstlane(tid >> 6), lane = tid & 63, wr = wid >> 2, wc = wid & 3, fr = lane & 15, fq = lane >> 4;
    const int K = g.K, nt = K / BK;
    unsigned voffA[2], voffB[2];
#pragma unroll
    for (int i = 0; i < 2; ++i) { int R, C; stage_rc(tid * 16 + i * 8192, R, C); const int Rb = Epi::PERM ? ((R & ~31) + perm32(R & 31)) : R;
        voffA[i] = (unsigned)(R * K + C) * 2u; voffB[i] = (unsigned)(Rb * K + C) * 2u; }
    const size_t kstep = (size_t)(BK * 2);
    const size_t hstep = (size_t)HALF * K * 2;
    const size_t tstep = 2 * hstep;
    const unsigned ldsw = (unsigned)wid * 1024u;
    const int aoff = lds_byte(wr * 64 + fr, fq * 8), boff = lds_byte(wc * 32 + fr, fq * 8);
#define PG8_SA(b, h) (((b) * 2 + (h)) * HTB)
#define PG8_SB(b, h) ((4 + (b) * 2 + (h)) * HTB)
#define PG8_STAGE(bufoff, gbase, voff) do { _Pragma("unroll") for (int _i = 0; _i < 2; ++_i) \
        __builtin_amdgcn_global_load_lds((const unsigned*)((const char*)(gbase) + (voff)[_i]), (PG8_LAS unsigned*)(lds + (bufoff) + ldsw + _i * 8192), 16, 0, 0); } while (0)
#define PG8_LDA(dst, b, h) do { _Pragma("unroll") for (int m = 0; m < 4; ++m) _Pragma("unroll") for (int k = 0; k < 2; ++k) dst[m][k] = *(const PG8_LAS bf16x8*)(lds + PG8_SA(b, h) + aoff + m * 2048 + k * 1024); } while (0)
#define PG8_LDB(dst, b, h) do { _Pragma("unroll") for (int n = 0; n < 2; ++n) _Pragma("unroll") for (int k = 0; k < 2; ++k) dst[n][k] = *(const PG8_LAS bf16x8*)(lds + PG8_SB(b, h) + boff + n * 2048 + k * 1024); } while (0)
#define PG8_MMA(ai, bj, At, Bt) do { __builtin_amdgcn_s_setprio(1); _Pragma("unroll") for (int m = 0; m < 4; ++m) _Pragma("unroll") for (int n = 0; n < 2; ++n) _Pragma("unroll") for (int k = 0; k < 2; ++k) \
        acc[ai][bj][m][n] = __builtin_amdgcn_mfma_f32_16x16x32_bf16(Bt[n][k], At[m][k], acc[ai][bj][m][n], 0, 0, 0); __builtin_amdgcn_s_setprio(0); } while (0)
#define PG8_WAIT_V(n) asm volatile("s_waitcnt vmcnt(" #n ")" ::: "memory")
#define PG8_WAIT_L(n) asm volatile("s_waitcnt lgkmcnt(" #n ")" ::: "memory")
#define PG8_BAR __builtin_amdgcn_s_barrier()
#define PG8_SCHED __builtin_amdgcn_sched_barrier(0)
    Unit cur, nxt; int ui = 0;
    if (!S.next(0, cur)) return;
    f32x4 acc[2][2][4][2];
#pragma unroll
    for (int a = 0; a < 2; ++a)
#pragma unroll
        for (int b = 0; b < 2; ++b)
#pragma unroll
            for (int m = 0; m < 4; ++m)
#pragma unroll
                for (int n = 0; n < 2; ++n) acc[a][b][m][n] = (f32x4){0.f, 0.f, 0.f, 0.f};
    bf16x8 At[4][2], B0[2][2], B1[2][2];
    const char* cA = (const char*)g.A + (size_t)cur.pm * tstep; const char* cB = (const char*)g.Bt + (size_t)cur.pn * tstep;
    S.a_ready(cur);
    PG8_STAGE(PG8_SB(0, 0), cB, voffB); PG8_STAGE(PG8_SA(0, 0), cA, voffA); PG8_STAGE(PG8_SB(0, 1), cB + hstep, voffB); PG8_STAGE(PG8_SA(0, 1), cA + hstep, voffA);
    if (wr == 1) PG8_BAR;
    PG8_WAIT_V(4); PG8_BAR;
    PG8_STAGE(PG8_SB(1, 0), cB + kstep, voffB); PG8_STAGE(PG8_SA(1, 0), cA + kstep, voffA); PG8_STAGE(PG8_SB(1, 1), cB + hstep + kstep, voffB);
    PG8_WAIT_V(6); PG8_BAR;
    for (;;) {
        const bool has_next = S.next(ui + 1, nxt);
        const char* nA = has_next ? (const char*)g.A + (size_t)nxt.pm * tstep : cA; const char* nB = has_next ? (const char*)g.Bt + (size_t)nxt.pn * tstep : cB;
        for (int t = 0; t < nt; t += 2) {
            const bool last = (t == nt - 2);
            const char* a1 = cA + (size_t)(t + 1) * kstep;
            const char* a2 = last ? nA : cA + (size_t)(t + 2) * kstep; const char* b2 = last ? nB : cB + (size_t)(t + 2) * kstep;
            const char* a3 = a2 + kstep; const char* b3 = b2 + kstep;
            if (last && has_next) S.a_ready(nxt);
            PG8_LDB(B0, 0, 0); PG8_SCHED; PG8_LDA(At, 0, 0); PG8_STAGE(PG8_SA(1, 1), a1 + hstep, voffA);
            PG8_WAIT_L(8); PG8_BAR; PG8_WAIT_L(0); PG8_MMA(0, 0, At, B0); PG8_BAR; PG8_SCHED;
            PG8_LDB(B1, 0, 1); PG8_STAGE(PG8_SB(0, 0), b2, voffB);
            PG8_BAR; PG8_WAIT_L(0); PG8_MMA(0, 1, At, B1); PG8_BAR;
            PG8_LDA(At, 0, 1); PG8_STAGE(PG8_SA(0, 0), a2, voffA);
            PG8_BAR; PG8_WAIT_L(0); PG8_MMA(1, 0, At, B0); PG8_BAR; PG8_SCHED;
            PG8_STAGE(PG8_SB(0, 1), b2 + hstep, voffB);
            PG8_WAIT_V(6); PG8_BAR; PG8_MMA(1, 1, At, B1); PG8_BAR;
            PG8_LDB(B0, 1, 0); PG8_SCHED; PG8_LDA(At, 1, 0); PG8_STAGE(PG8_SA(0, 1), a2 + hstep, voffA);
            PG8_WAIT_L(8); PG8_BAR; PG8_WAIT_L(0); PG8_MMA(0, 0, At, B0); PG8_BAR; PG8_SCHED;
            PG8_LDB(B1, 1, 1); PG8_STAGE(PG8_SB(1, 0), b3, voffB);
            PG8_BAR; PG8_WAIT_L(0); PG8_MMA(0, 1, At, B1); PG8_BAR;
            PG8_LDA(At, 1, 1); PG8_STAGE(PG8_SA(1, 0), a3, voffA);
            PG8_BAR; PG8_WAIT_L(0); PG8_MMA(1, 0, At, B0); PG8_BAR; PG8_SCHED;
            PG8_STAGE(PG8_SB(1, 1), b3 + hstep, voffB);
            PG8_WAIT_V(6); PG8_BAR; PG8_MMA(1, 1, At, B1); PG8_BAR;
        }
        E(acc, cur, wr, wc, fr, fq); S.done(cur);
        if (!has_next) break;
#pragma unroll
        for (int a = 0; a < 2; ++a)
#pragma unroll
            for (int b = 0; b < 2; ++b)
#pragma unroll
                for (int m = 0; m < 4; ++m)
#pragma unroll
                    for (int n = 0; n < 2; ++n) acc[a][b][m][n] = (f32x4){0.f, 0.f, 0.f, 0.f};
        cur = nxt; cA = nA; cB = nB; ++ui;
    }
    PG8_WAIT_V(0);
    if (wr == 0) PG8_BAR;
    PG8_BAR;
#undef PG8_SA
#undef PG8_SB
#undef PG8_STAGE
#undef PG8_LDA
#undef PG8_LDB
#undef PG8_MMA
#undef PG8_WAIT_V
#undef PG8_WAIT_L
#undef PG8_BAR
#undef PG8_SCHED
}

struct EpiBf16 {
    static constexpr bool PERM = true;
    bf16_t* O; int ldc, pad;
    __device__ __forceinline__ void operator()(const f32x4 (&acc)[2][2][4][2], const Unit& u, int wr, int wc, int fr, int fq) const {
        const int row0 = u.pm * BM + wr * 64 + fr, col0 = u.pn * BM + wc * 32 + 8 * fq;
#pragma unroll
        for (int ai = 0; ai < 2; ++ai)
#pragma unroll
            for (int m = 0; m < 4; ++m) { bf16_t* rowp = O + (size_t)(row0 + ai * HALF + m * 16) * ldc + col0;
#pragma unroll
                for (int bj = 0; bj < 2; ++bj) { const f32x4 v0 = acc[ai][bj][m][0], v1 = acc[ai][bj][m][1];
                    u32x4 w; w.x = cvt_pk_bf16(v0[0], v0[1]); w.y = cvt_pk_bf16(v0[2], v0[3]); w.z = cvt_pk_bf16(v1[0], v1[1]); w.w = cvt_pk_bf16(v1[2], v1[3]);
                    *(u32x4*)(rowp + bj * HALF) = w; } }
    }
};
struct EpiF32 {
    static constexpr bool PERM = false;
    float* C; int ldc, pad;
    __device__ __forceinline__ void operator()(const f32x4 (&acc)[2][2][4][2], const Unit& u, int wr, int wc, int fr, int fq) const {
        const int row0 = u.pm * BM + wr * 64 + fr, col0 = u.pn * BM + wc * 32 + 4 * fq;
#pragma unroll
        for (int ai = 0; ai < 2; ++ai)
#pragma unroll
            for (int m = 0; m < 4; ++m) { float* rowp = C + (size_t)(row0 + ai * HALF + m * 16) * ldc + col0;
#pragma unroll
                for (int bj = 0; bj < 2; ++bj)
#pragma unroll
                    for (int n = 0; n < 2; ++n) *(f32x4*)(rowp + bj * HALF + n * 16) = acc[ai][bj][m][n]; }
    }
};
struct EpiRes {
    static constexpr bool PERM = false;
    const float* R; float* C; int ldc; float alpha;
    __device__ __forceinline__ void operator()(const f32x4 (&acc)[2][2][4][2], const Unit& u, int wr, int wc, int fr, int fq) const {
        const int row0 = u.pm * BM + wr * 64 + fr, col0 = u.pn * BM + wc * 32 + 4 * fq;
#pragma unroll
        for (int ai = 0; ai < 2; ++ai)
#pragma unroll
            for (int m = 0; m < 4; ++m) { const size_t off = (size_t)(row0 + ai * HALF + m * 16) * ldc + col0;
#pragma unroll
                for (int bj = 0; bj < 2; ++bj)
#pragma unroll
                    for (int n = 0; n < 2; ++n) { const f32x4 r = *(const f32x4*)(R + off + bj * HALF + n * 16); *(f32x4*)(C + off + bj * HALF + n * 16) = r * alpha + acc[ai][bj][m][n]; }
                asm volatile("" ::: "memory"); }
    }
};
}
using pg8::bf16_t;
constexpr int DM = 2048, NB_ = 8, SEQ = 4096, NT = NB_ * SEQ, DEPTH = 4, NMEM = 256, HD = 128;
constexpr int LOCALW = 1536, MEMW = 512, NEXP = 16384;
constexpr float ALPHA = 1.6817928305074290861f;
constexpr float LN_EPS = 1e-5f;
constexpr float QSCALE = 0.08838834764831845f;

__device__ __forceinline__ unsigned pk_bf16(float lo, float hi) { unsigned r; asm volatile("v_cvt_pk_bf16_f32 %0, %1, %2" : "=v"(r) : "v"(lo), "v"(hi)); return r; }
__device__ __forceinline__ float bf_lo(unsigned x) { return __uint_as_float(x << 16); }
__device__ __forceinline__ float bf_hi(unsigned x) { return __uint_as_float(x & 0xffff0000u); }
__device__ __forceinline__ float wave_sum(float v) {
#pragma unroll
    for (int o = 32; o >= 1; o >>= 1) v += __shfl_xor(v, o);
    return v;
}

__global__ void k_cvt(const float* __restrict__ src, bf16_t* __restrict__ dst, size_t n8) {
    for (size_t i = (size_t)blockIdx.x * blockDim.x + threadIdx.x; i < n8; i += (size_t)gridDim.x * blockDim.x) {
        const float4 a = ((const float4*)src)[2 * i], b = ((const float4*)src)[2 * i + 1];
        uint4 o; o.x = pk_bf16(a.x, a.y); o.y = pk_bf16(a.z, a.w); o.z = pk_bf16(b.x, b.y); o.w = pk_bf16(b.z, b.w);
        ((uint4*)dst)[i] = o;
    }
}
__global__ void k_transpose_cvt(const float* __restrict__ src, int lds_, bf16_t* __restrict__ dst, int ldd) {
    __shared__ float tile[64][65];
    const int k0 = blockIdx.y * 64, n0 = blockIdx.x * 64, tx = threadIdx.x & 63, ty = threadIdx.x >> 6;
    for (int r = ty; r < 64; r += 4) tile[r][tx] = src[(size_t)(k0 + r) * lds_ + n0 + tx];
    __syncthreads();
    for (int r = ty; r < 64; r += 4) dst[(size_t)(n0 + r) * ldd + k0 + tx] = (bf16_t)(pk_bf16(tile[tx][r], 0.f) & 0xffffu);
}
template <bool B_NMAJOR>
__global__ void k_fold(const float* __restrict__ A, int lda, const float* __restrict__ Bm, const float* __restrict__ scale, bf16_t* __restrict__ Out, int NB, int KI) {
    __shared__ float As[64][33];
    __shared__ float Bs[32][65];
    const int grp = blockIdx.z, n0 = blockIdx.y * 64, k0 = blockIdx.x * 64, tid = threadIdx.x, tx = tid & 15, ty = tid >> 4;
    float acc[4][4];
#pragma unroll
    for (int a = 0; a < 4; ++a)
#pragma unroll
        for (int b = 0; b < 4; ++b) acc[a][b] = 0.f;
    const float* Bg = Bm + (size_t)grp * NB * KI;
    for (int i0 = 0; i0 < KI; i0 += 32) {
        for (int e = tid; e < 2048; e += 256) { const int r = e >> 5, c = e & 31; As[r][c] = A[(size_t)(k0 + r) * lda + grp * KI + i0 + c]; }
        for (int e = tid; e < 2048; e += 256) {
            if (!B_NMAJOR) { const int r = e >> 6, c = e & 63; Bs[r][c] = Bg[(size_t)(i0 + r) * NB + n0 + c]; }
            else { const int c = e >> 5, r = e & 31; Bs[r][c] = Bg[(size_t)(n0 + c) * KI + i0 + r]; }
        }
        __syncthreads();
#pragma unroll 8
        for (int i = 0; i < 32; ++i) {
            float a[4], b[4];
#pragma unroll
            for (int q = 0; q < 4; ++q) { a[q] = As[tx * 4 + q][i]; b[q] = Bs[i][ty * 4 + q]; }
#pragma unroll
            for (int nn = 0; nn < 4; ++nn)
#pragma unroll
                for (int kk = 0; kk < 4; ++kk) acc[nn][kk] += b[nn] * a[kk];
        }
        __syncthreads();
    }
#pragma unroll
    for (int nn = 0; nn < 4; ++nn) {
        const int n = n0 + ty * 4 + nn; const float s = scale ? scale[grp * NB + n] : 1.0f;
        uint2 o; o.x = pk_bf16(acc[nn][0] * s, acc[nn][1] * s); o.y = pk_bf16(acc[nn][2] * s, acc[nn][3] * s);
        *(uint2*)(Out + (size_t)(grp * NB + n) * DM + k0 + tx * 4) = o;
    }
}

__global__ void k_pool(const bf16_t* __restrict__ h, bf16_t* __restrict__ mix) {
    const size_t total = (size_t)NT * 192;
    for (size_t idx = (size_t)blockIdx.x * blockDim.x + threadIdx.x; idx < total; idx += (size_t)gridDim.x * blockDim.x) {
        const int tok = (int)(idx / 192), c = (int)(idx % 192) * 8, g = c / 384, w = 2 << g, t = tok % SEQ;
        const int cnt = (t + 1) < w ? (t + 1) : w;
        float s[8];
#pragma unroll
        for (int j = 0; j < 8; ++j) s[j] = 0.f;
        const bf16_t* p = h + (size_t)tok * DM + c;
        const uint4 cur = *(const uint4*)p;
        for (int i = 0; i < cnt; ++i) {
            const uint4 v = *(const uint4*)(p - (size_t)i * DM);
            s[0] += bf_lo(v.x); s[1] += bf_hi(v.x); s[2] += bf_lo(v.y); s[3] += bf_hi(v.y); s[4] += bf_lo(v.z); s[5] += bf_hi(v.z); s[6] += bf_lo(v.w); s[7] += bf_hi(v.w);
        }
        const float inv = 1.0f / (float)cnt;
        uint4 o;
        o.x = pk_bf16(s[0] * inv - bf_lo(cur.x), s[1] * inv - bf_hi(cur.x)); o.y = pk_bf16(s[2] * inv - bf_lo(cur.y), s[3] * inv - bf_hi(cur.y));
        o.z = pk_bf16(s[4] * inv - bf_lo(cur.z), s[5] * inv - bf_hi(cur.z)); o.w = pk_bf16(s[6] * inv - bf_lo(cur.w), s[7] * inv - bf_hi(cur.w));
        *(uint4*)(mix + (size_t)tok * DM + c) = o;
    }
}

__global__ void k_memattn(const bf16_t* __restrict__ h, int ldh, int qoff, const bf16_t* __restrict__ kv, int layer, bf16_t* __restrict__ mix) {
    const int lane = threadIdx.x & 63; const int wave = (blockIdx.x * blockDim.x + threadIdx.x) >> 6, nw = (gridDim.x * blockDim.x) >> 6;
    for (int task = wave; task < NT * 4; task += nw) {
        const int tok = task >> 2, hh = task & 3, b = tok / SEQ;
        const unsigned qq = *(const unsigned*)(h + (size_t)tok * ldh + qoff + hh * HD + 2 * lane);
        const float q0 = bf_lo(qq) * QSCALE, q1 = bf_hi(qq) * QSCALE;
        const bf16_t* kb = kv + (size_t)(b * NMEM) * 4096 + layer * 1024 + hh * HD + 2 * lane; const bf16_t* vb = kb + 512;
        float m = -1e30f, l = 0.f, a0 = 0.f, a1 = 0.f;
#pragma unroll 4
        for (int j = 0; j < NMEM; ++j) {
            const unsigned kk = *(const unsigned*)(kb + (size_t)j * 4096), vv = *(const unsigned*)(vb + (size_t)j * 4096);
            const float s = wave_sum(q0 * bf_lo(kk) + q1 * bf_hi(kk));
            const float mn = fmaxf(m, s), corr = __expf(m - mn), e = __expf(s - mn);
            l = l * corr + e; a0 = a0 * corr + e * bf_lo(vv); a1 = a1 * corr + e * bf_hi(vv); m = mn;
        }
        const float inv = 1.0f / l;
        *(unsigned*)(mix + (size_t)tok * DM + LOCALW + hh * HD + 2 * lane) = pk_bf16(a0 * inv, a1 * inv);
    }
}
__global__ void k_dilattn(const bf16_t* __restrict__ h  , bf16_t* __restrict__ mix) {
    const int lane = threadIdx.x & 63; const int wave = (blockIdx.x * blockDim.x + threadIdx.x) >> 6, nw = (gridDim.x * blockDim.x) >> 6;
    for (int task = wave; task < NT * 4; task += nw) {
        const int tok = task >> 2, hh = task & 3, t = tok % SEQ;
        float o0[3], o1[3], lse[3];
#pragma unroll
        for (int g = 0; g < 3; ++g) {
            const int dil = (g == 0) ? 1 : (g == 1 ? 4 : 16);
            const int col = g * 512 + hh * HD + 2 * lane;
            const unsigned qq = *(const unsigned*)(h + (size_t)tok * 5120 + col);
            const float q0 = bf_lo(qq) * QSCALE, q1 = bf_hi(qq) * QSCALE;
            const bf16_t* kb = h + (size_t)tok * 5120 + LOCALW + col; const bf16_t* vb = kb + LOCALW;
            int nk = t / dil + 1; if (nk > 129) nk = 129;
            float m = -1e30f, l = 0.f, a0 = 0.f, a1 = 0.f;
#pragma unroll 4
            for (int j = 0; j < nk; ++j) {
                const size_t ro = (size_t)j * dil * 5120;
                const unsigned kk = *(const unsigned*)(kb - ro), vv = *(const unsigned*)(vb - ro);
                const float s = wave_sum(q0 * bf_lo(kk) + q1 * bf_hi(kk));
                const float mn = fmaxf(m, s), corr = __expf(m - mn), e = __expf(s - mn);
                l = l * corr + e; a0 = a0 * corr + e * bf_lo(vv); a1 = a1 * corr + e * bf_hi(vv); m = mn;
            }
            const float inv = 1.0f / l; o0[g] = a0 * inv; o1[g] = a1 * inv; lse[g] = m + __logf(l);
        }
        const float mx = fmaxf(lse[0], fmaxf(lse[1], lse[2]));
        const float e0 = __expf(lse[0] - mx), e1 = __expf(lse[1] - mx), e2 = __expf(lse[2] - mx), inv = 1.0f / (e0 + e1 + e2);
        const float al[3] = {e0 * inv, e1 * inv, e2 * inv};
#pragma unroll
        for (int g = 0; g < 3; ++g) *(unsigned*)(mix + (size_t)tok * DM + g * 512 + hh * HD + 2 * lane) = pk_bf16(o0[g] * al[g], o1[g] * al[g]);
    }
}

__global__ void k_ln(float* __restrict__ y, const float* __restrict__ gam, const float* __restrict__ bet, bf16_t* __restrict__ xb) {
    const int lane = threadIdx.x & 63; const int wave = (blockIdx.x * blockDim.x + threadIdx.x) >> 6, nw = (gridDim.x * blockDim.x) >> 6;
    for (int row = wave; row < NT; row += nw) {
        float4 v[8]; float s = 0.f;
#pragma unroll
        for (int c = 0; c < 8; ++c) { v[c] = *(const float4*)(y + (size_t)row * DM + c * 256 + lane * 4); s += (v[c].x + v[c].y) + (v[c].z + v[c].w); }
        const float mean = wave_sum(s) * (1.0f / DM); float q = 0.f;
#pragma unroll
        for (int c = 0; c < 8; ++c) { const float a = v[c].x - mean, b = v[c].y - mean, cc = v[c].z - mean, d = v[c].w - mean; q += (a * a + b * b) + (cc * cc + d * d); }
        const float rstd = rsqrtf(wave_sum(q) * (1.0f / DM) + LN_EPS);
#pragma unroll
        for (int c = 0; c < 8; ++c) {
            const int col = c * 256 + lane * 4; const float4 g4 = *(const float4*)(gam + col), b4 = *(const float4*)(bet + col);
            float4 o; o.x = (v[c].x - mean) * rstd * g4.x + b4.x; o.y = (v[c].y - mean) * rstd * g4.y + b4.y; o.z = (v[c].z - mean) * rstd * g4.z + b4.z; o.w = (v[c].w - mean) * rstd * g4.w + b4.w;
            *(float4*)(y + (size_t)row * DM + col) = o;
            uint2 p; p.x = pk_bf16(o.x, o.y); p.y = pk_bf16(o.z, o.w); *(uint2*)(xb + (size_t)row * DM + col) = p;
        }
    }
}

__device__ __forceinline__ void tk_insert(float (&L)[16], float x) {
#pragma unroll
    for (int i = 15; i >= 1; --i) L[i] = __builtin_amdgcn_fmed3f(L[i - 1], L[i], x);
    L[0] = fmaxf(L[0], x);
}
__global__ __launch_bounds__(256) void k_topk(const float* __restrict__ scores, int* __restrict__ eidx, float* __restrict__ gate) {
    __shared__ float vbuf[4][16][17];
    const int lane = threadIdx.x & 63, w = threadIdx.x >> 6;
    const int per_blk = (NT + gridDim.x * 4 - 1) / (gridDim.x * 4);
    for (int it = 0; it < per_blk; ++it) {
        const int tok = (blockIdx.x * 4 + w) * per_blk + it;
        const bool ok = tok < NT;
        if (ok && lane < 16) {
            const float* s = scores + (size_t)tok * DM + lane * 128;
            float L[16];
#pragma unroll
            for (int i = 0; i < 16; ++i) L[i] = -__builtin_inff();
            for (int n = 0; n < 128; n += 4) {
                const float4 v = *(const float4*)(s + n);
                tk_insert(L, __uint_as_float((__float_as_uint(v.x) & ~127u) | (unsigned)(n + 0)));
                tk_insert(L, __uint_as_float((__float_as_uint(v.y) & ~127u) | (unsigned)(n + 1)));
                tk_insert(L, __uint_as_float((__float_as_uint(v.z) & ~127u) | (unsigned)(n + 2)));
                tk_insert(L, __uint_as_float((__float_as_uint(v.w) & ~127u) | (unsigned)(n + 3)));
            }
#pragma unroll
            for (int i = 0; i < 16; ++i) vbuf[w][lane][i] = L[i];
        }
        __syncthreads();
        if (ok && lane < 8) {
            float v1[16], v2[16], M[16];
#pragma unroll
            for (int i = 0; i < 16; ++i) { v1[i] = vbuf[w][2 * lane][i]; v2[i] = vbuf[w][2 * lane + 1][i]; M[i] = -__builtin_inff(); }
#pragma unroll
            for (int a = 0; a < 16; ++a)
#pragma unroll
                for (int b = 0; b < 16; ++b)
                    if ((a + 1) * (b + 1) <= 16) tk_insert(M, __uint_as_float((__float_as_uint(v1[a] + v2[b]) & ~255u) | (unsigned)(a * 16 + b)));
            float e[16], sum = 0.f;
#pragma unroll
            for (int k = 0; k < 16; ++k) { e[k] = __expf(M[k] - M[0]); sum += e[k]; }
            const float inv = 1.0f / sum;
#pragma unroll
            for (int k = 0; k < 16; ++k) {
                const unsigned code = __float_as_uint(M[k]) & 255u; const int a = code >> 4, b = code & 15;
                const unsigned i1 = __float_as_uint(vbuf[w][2 * lane][a]) & 127u, i2 = __float_as_uint(vbuf[w][2 * lane + 1][b]) & 127u;
                eidx[(size_t)tok * 128 + lane * 16 + k] = (int)(i1 * 128u + i2);
                gate[(size_t)tok * 128 + lane * 16 + k] = e[k] * inv;
            }
        }
        __syncthreads();
    }
}

__global__ __launch_bounds__(256) void k_peer(float* __restrict__ xio, const int* __restrict__ eidx, const float* __restrict__ gate, const bf16_t* __restrict__ U, const bf16_t* __restrict__ V,
                                             const float* __restrict__ gam, const float* __restrict__ bet, bf16_t* __restrict__ xb) {
    const int lane = threadIdx.x & 63; const int wave = (blockIdx.x * blockDim.x + threadIdx.x) >> 6, nw = (gridDim.x * blockDim.x) >> 6;
    for (int tok = wave; tok < NT; tok += nw) {
        float x[32];
#pragma unroll
        for (int c = 0; c < 4; ++c) { const float4 a = *(const float4*)(xio + (size_t)tok * DM + c * 512 + lane * 8), b = *(const float4*)(xio + (size_t)tok * DM + c * 512 + lane * 8 + 4);
            x[c * 8 + 0] = a.x; x[c * 8 + 1] = a.y; x[c * 8 + 2] = a.z; x[c * 8 + 3] = a.w; x[c * 8 + 4] = b.x; x[c * 8 + 5] = b.y; x[c * 8 + 6] = b.z; x[c * 8 + 7] = b.w; }
        const int e0 = eidx[(size_t)tok * 128 + lane], e1 = eidx[(size_t)tok * 128 + 64 + lane];
        const float g0 = gate[(size_t)tok * 128 + lane], g1 = gate[(size_t)tok * 128 + 64 + lane];
        float a0 = 0.f, a1 = 0.f;
#pragma unroll 2
        for (int k = 0; k < 128; ++k) {
            const int e = __builtin_amdgcn_readlane(k < 64 ? e0 : e1, k & 63);
            const bf16_t* ur = U + (size_t)e * DM + lane * 8;
            float p = 0.f;
#pragma unroll
            for (int c = 0; c < 4; ++c) { const uint4 u = *(const uint4*)(ur + c * 512);
                p += x[c * 8 + 0] * bf_lo(u.x) + x[c * 8 + 1] * bf_hi(u.x) + x[c * 8 + 2] * bf_lo(u.y) + x[c * 8 + 3] * bf_hi(u.y)
                   + x[c * 8 + 4] * bf_lo(u.z) + x[c * 8 + 5] * bf_hi(u.z) + x[c * 8 + 6] * bf_lo(u.w) + x[c * 8 + 7] * bf_hi(u.w); }
            p = wave_sum(p);
            if (lane == (k & 63)) { if (k < 64) a0 = p; else a1 = p; }
        }
        const float w0 = g0 * 0.5f * a0 * (1.0f + erff(a0 * 0.70710678118654752f)), w1 = g1 * 0.5f * a1 * (1.0f + erff(a1 * 0.70710678118654752f));
        float acc[32];
#pragma unroll
        for (int i = 0; i < 32; ++i) acc[i] = 0.f;
#pragma unroll 2
        for (int k = 0; k < 128; ++k) {
            const int e = __builtin_amdgcn_readlane(k < 64 ? e0 : e1, k & 63);
            const float wk = __builtin_bit_cast(float, __builtin_amdgcn_readlane(__builtin_bit_cast(int, k < 64 ? w0 : w1), k & 63));
            const bf16_t* vr = V + (size_t)e * DM + lane * 8;
#pragma unroll
            for (int c = 0; c < 4; ++c) { const uint4 u = *(const uint4*)(vr + c * 512);
                acc[c * 8 + 0] += wk * bf_lo(u.x); acc[c * 8 + 1] += wk * bf_hi(u.x); acc[c * 8 + 2] += wk * bf_lo(u.y); acc[c * 8 + 3] += wk * bf_hi(u.y);
                acc[c * 8 + 4] += wk * bf_lo(u.z); acc[c * 8 + 5] += wk * bf_hi(u.z); acc[c * 8 + 6] += wk * bf_lo(u.w); acc[c * 8 + 7] += wk * bf_hi(u.w); }
        }
        float s = 0.f;
#pragma unroll
        for (int i = 0; i < 32; ++i) { acc[i] = ALPHA * x[i] + acc[i]; s += acc[i]; }
        const float mean = wave_sum(s) * (1.0f / DM); float q = 0.f;
#pragma unroll
        for (int i = 0; i < 32; ++i) { const float d = acc[i] - mean; q += d * d; }
        const float rstd = rsqrtf(wave_sum(q) * (1.0f / DM) + LN_EPS);
#pragma unroll
        for (int c = 0; c < 4; ++c) {
            const int col = c * 512 + lane * 8;
            const float4 ga = *(const float4*)(gam + col), gb = *(const float4*)(gam + col + 4), ba = *(const float4*)(bet + col), bb = *(const float4*)(bet + col + 4);
            float4 oa, ob;
            oa.x = (acc[c * 8 + 0] - mean) * rstd * ga.x + ba.x; oa.y = (acc[c * 8 + 1] - mean) * rstd * ga.y + ba.y; oa.z = (acc[c * 8 + 2] - mean) * rstd * ga.z + ba.z; oa.w = (acc[c * 8 + 3] - mean) * rstd * ga.w + ba.w;
            ob.x = (acc[c * 8 + 4] - mean) * rstd * gb.x + bb.x; ob.y = (acc[c * 8 + 5] - mean) * rstd * gb.y + bb.y; ob.z = (acc[c * 8 + 6] - mean) * rstd * gb.z + bb.z; ob.w = (acc[c * 8 + 7] - mean) * rstd * gb.w + bb.w;
            *(float4*)(xio + (size_t)tok * DM + col) = oa; *(float4*)(xio + (size_t)tok * DM + col + 4) = ob;
            uint4 p; p.x = pk_bf16(oa.x, oa.y); p.y = pk_bf16(oa.z, oa.w); p.z = pk_bf16(ob.x, ob.y); p.w = pk_bf16(ob.z, ob.w);
            *(uint4*)(xb + (size_t)tok * DM + col) = p;
        }
    }
}
template <class Epi> __global__ __launch_bounds__(512, 2) void k_gemm(pg8::Gemm g, Epi E) {
    extern __shared__ __attribute__((aligned(16))) unsigned char shm[];
    pg8::StaticOrder S; S.init(g.M, g.N, (int)gridDim.x, (int)blockIdx.x);
    pg8::gemm_phase<Epi, pg8::StaticOrder>((PG8_LAS unsigned char*)shm, g, S, E);
}
template <class Epi> static void launch_gemm(const bf16_t* A, const bf16_t* Bt, int M, int N, int K, const Epi& E, hipStream_t st) {
    static bool attr = false;
    if (!attr) { hipFuncSetAttribute((const void*)k_gemm<Epi>, hipFuncAttributeMaxDynamicSharedMemorySize, pg8::STAGE_BYTES); attr = true; }
    pg8::Gemm g{}; g.A = A; g.Bt = Bt; g.M = M; g.N = N; g.K = K;
    hipLaunchKernelGGL((k_gemm<Epi>), dim3(256), dim3(512), pg8::STAGE_BYTES, st, g, E);
}

constexpr size_t MB = 1024ull * 1024ull;
constexpr size_t OFF_WT_IN0 = 1 * MB;
constexpr size_t OFF_WT_IN1 = OFF_WT_IN0 + 8 * MB;
constexpr size_t OFF_WT_IN2 = OFF_WT_IN1 + 20 * MB;
constexpr size_t OFF_WT_IN3 = OFF_WT_IN2 + 8 * MB;
constexpr size_t OFF_WT_KV  = OFF_WT_IN3 + 20 * MB;
constexpr size_t OFF_WT_O   = OFF_WT_KV + 16 * MB;
constexpr size_t OFF_WT_S   = OFF_WT_O + 32 * MB;
constexpr size_t OFF_MEMBF  = OFF_WT_S + 32 * MB;
constexpr size_t OFF_KV     = OFF_MEMBF + 8 * MB;
constexpr size_t OFF_U      = OFF_KV + 16 * MB;
constexpr size_t OFF_V      = OFF_U + 256 * MB;
constexpr size_t OFF_XBF    = OFF_V + 256 * MB;
constexpr size_t OFF_H      = OFF_XBF + 128 * MB;
constexpr size_t OFF_MIX    = OFF_H + 320 * MB;
constexpr size_t OFF_EIDX   = OFF_MIX + 128 * MB;
constexpr size_t OFF_GATE   = OFF_EIDX + 16 * MB;
constexpr size_t WS_NEED    = OFF_GATE + 16 * MB;

extern "C" void kernel_launch(void* const* d_in, const int* in_sizes, int n_in, void* d_out, int out_size, void* d_ws, size_t ws_size, hipStream_t stream) {
    const float* x = (const float*)d_in[0]; const float* mem = (const float*)d_in[1]; const float* w_in_a = (const float*)d_in[2]; const float* w_pool = (const float*)d_in[3];
    const float* s_pool = (const float*)d_in[4]; const float* w_in_b = (const float*)d_in[5]; const float* w_mem_kv = (const float*)d_in[6]; const float* w_o = (const float*)d_in[7];
    const float* ln_g = (const float*)d_in[8]; const float* ln_b = (const float*)d_in[9]; const float* peer_wq = (const float*)d_in[10]; const float* peer_keys = (const float*)d_in[11];
    const float* peer_u = (const float*)d_in[12]; const float* peer_v = (const float*)d_in[13];
    float* out = (float*)d_out; char* ws = (char*)d_ws;
    if (ws_size < WS_NEED) return;
    bf16_t* wt_in[4] = {(bf16_t*)(ws + OFF_WT_IN0), (bf16_t*)(ws + OFF_WT_IN1), (bf16_t*)(ws + OFF_WT_IN2), (bf16_t*)(ws + OFF_WT_IN3)};
    bf16_t* wt_kv = (bf16_t*)(ws + OFF_WT_KV); bf16_t* wt_o = (bf16_t*)(ws + OFF_WT_O); bf16_t* wt_s = (bf16_t*)(ws + OFF_WT_S);
    bf16_t* membf = (bf16_t*)(ws + OFF_MEMBF); bf16_t* kv = (bf16_t*)(ws + OFF_KV); bf16_t* U = (bf16_t*)(ws + OFF_U); bf16_t* V = (bf16_t*)(ws + OFF_V);
    bf16_t* xbf = (bf16_t*)(ws + OFF_XBF); bf16_t* h = (bf16_t*)(ws + OFF_H); float* scores = (float*)(ws + OFF_H); bf16_t* mix = (bf16_t*)(ws + OFF_MIX);
    int* eidx = (int*)(ws + OFF_EIDX); float* gate = (float*)(ws + OFF_GATE);
    const size_t WSQ = (size_t)DM * DM;

    k_cvt<<<2048, 256, 0, stream>>>(x, xbf, (size_t)NT * DM / 8);
    k_cvt<<<512, 256, 0, stream>>>(mem, membf, (size_t)NB_ * NMEM * DM / 8);
    k_cvt<<<4096, 256, 0, stream>>>(peer_u, U, (size_t)DEPTH * NEXP * DM / 8);
    k_cvt<<<4096, 256, 0, stream>>>(peer_v, V, (size_t)DEPTH * NEXP * DM / 8);
    for (int l = 0; l < DEPTH; ++l) {
        if ((l & 1) == 0) {
            const int ia = l >> 1;
            k_fold<false><<<dim3(32, 6, 4), 256, 0, stream>>>(w_in_a + (size_t)ia * WSQ, DM, w_pool + (size_t)ia * 4 * 384 * 384, s_pool + (size_t)ia * LOCALW, wt_in[l], 384, 384);
            k_transpose_cvt<<<dim3(MEMW / 64, DM / 64), 256, 0, stream>>>(w_in_a + (size_t)ia * WSQ + LOCALW, DM, wt_in[l] + (size_t)LOCALW * DM, DM);
        } else {
            const int ib = l >> 1;
            k_transpose_cvt<<<dim3(5120 / 64, DM / 64), 256, 0, stream>>>(w_in_b + (size_t)ib * DM * 5120, 5120, wt_in[l], DM);
        }
        k_transpose_cvt<<<dim3(1024 / 64, DM / 64), 256, 0, stream>>>(w_mem_kv + (size_t)l * DM * 1024, 1024, wt_kv + (size_t)l * 1024 * DM, DM);
        k_transpose_cvt<<<dim3(DM / 64, DM / 64), 256, 0, stream>>>(w_o + (size_t)l * WSQ, DM, wt_o + (size_t)l * WSQ, DM);
        k_fold<true><<<dim3(32, 2, 16), 256, 0, stream>>>(peer_wq + (size_t)l * WSQ, DM, peer_keys + (size_t)l * 16 * 128 * 128, nullptr, wt_s + (size_t)l * WSQ, 128, 128);
    }
    { pg8::EpiBf16 E{}; E.O = kv; E.ldc = 4096; launch_gemm(membf, wt_kv, NB_ * NMEM, 4096, DM, E, stream); }

    for (int l = 0; l < DEPTH; ++l) {
        const bool pool = (l & 1) == 0; const int ldh = pool ? DM : 5120;
        { pg8::EpiBf16 E{}; E.O = h; E.ldc = ldh; launch_gemm(xbf, wt_in[l], NT, ldh, DM, E, stream); }
        if (pool) k_pool<<<4096, 256, 0, stream>>>(h, mix); else k_dilattn<<<4096, 256, 0, stream>>>(h, mix);
        k_memattn<<<4096, 256, 0, stream>>>(h, ldh, ldh - MEMW, kv, l, mix);
        { pg8::EpiRes E{}; E.R = (l == 0) ? x : out; E.C = out; E.ldc = DM; E.alpha = ALPHA; launch_gemm(mix, wt_o + (size_t)l * WSQ, NT, DM, DM, E, stream); }
        k_ln<<<2048, 256, 0, stream>>>(out, ln_g + (size_t)(l * 2 + 0) * DM, ln_b + (size_t)(l * 2 + 0) * DM, xbf);
        { pg8::EpiF32 E{}; E.C = scores; E.ldc = DM; launch_gemm(xbf, wt_s + (size_t)l * WSQ, NT, DM, DM, E, stream); }
        k_topk<<<2048, 256, 0, stream>>>(scores, eidx, gate);
        k_peer<<<4096, 256, 0, stream>>>(out, eidx, gate, U + (size_t)l * NEXP * DM, V + (size_t)l * NEXP * DM, ln_g + (size_t)(l * 2 + 1) * DM, ln_b + (size_t)(l * 2 + 1) * DM, xbf);
    }
}
```

```cpp
#include <hip/hip_runtime.h>
#include <stdint.h>
#define PG8_ALIGN_DEFAULT true
#define PG8_SP2_DEFAULT true
namespace pg8 {
#define PG8_LAS __attribute__((address_space(3)))
typedef unsigned short bf16_t;
typedef short bf16x8 __attribute__((ext_vector_type(8)));
typedef float f32x4 __attribute__((ext_vector_type(4)));
typedef unsigned u32x4 __attribute__((ext_vector_type(4)));
constexpr int BM = 256, BK = 64, HALF = 128, HTB = HALF * BK * 2  , STAGE_BYTES = 8 * HTB, NXCD = 8, WGM = 8;

__host__ __device__ __forceinline__ int lds_byte(int r, int c) { const int st = (r >> 4) * 2 + (c >> 5), rr = r & 15, cc = c & 31, ob = rr * 64 + cc * 2; return st * 1024 + (ob ^ (((ob >> 9) & 1) << 5)); }
__host__ __device__ __forceinline__ void stage_rc(int b, int& R, int& C) { const int st = b / 1024, sb = b % 1024, swz = sb ^ (((sb >> 9) & 1) << 5); R = (st >> 1) * 16 + swz / 64; C = (st & 1) * 32 + (swz % 64) / 2; }
__host__ __device__ __forceinline__ int perm32(int rho) { const int n = rho >> 4, i = rho & 15; return 8 * (i >> 2) + 4 * n + (i & 3); }

struct Unit { int pm, pn; };
struct Gemm { const bf16_t* A; const bf16_t* Bt; int M, N, K, bdil; };

struct StaticOrder {
    int nM, nN, nwg, G, c;
    __host__ __device__ void init(int M, int N, int G_, int c_) { nM = M / BM; nN = N / BM; nwg = nM * nN; G = G_; c = c_; }
    __host__ __device__ bool next(int i, Unit& u) const {
        const long L = (long)i * G + c; if (L >= nwg) return false;
        int wgid = (int)L; { const int q = nwg / NXCD, r = nwg % NXCD, xcd = wgid % NXCD, off = wgid / NXCD; wgid = (xcd < r ? xcd * (q + 1) : r * (q + 1) + (xcd - r) * q) + off; }
        const int nig = WGM * nN, gid = wgid / nig, fm = gid * WGM, gsz = (nM - fm) < WGM ? (nM - fm) : WGM;
        u.pm = fm + ((wgid % nig) % gsz); u.pn = (wgid % nig) / gsz; return true;
    }
    __device__ __forceinline__ void a_ready(const Unit&) const {}
    __device__ __forceinline__ void done(const Unit&) const {}
};

__device__ __forceinline__ unsigned pk4_fp8(float a, float b, float c, float d) {
    a = fminf(fmaxf(a, -448.f), 448.f); b = fminf(fmaxf(b, -448.f), 448.f); c = fminf(fmaxf(c, -448.f), 448.f); d = fminf(fmaxf(d, -448.f), 448.f);
    int r = __builtin_amdgcn_cvt_pk_fp8_f32(a, b, 0, false); r = __builtin_amdgcn_cvt_pk_fp8_f32(c, d, r, true); return (unsigned)r; }
__device__ __forceinline__ unsigned cvt_pk_bf16(float lo, float hi) { unsigned r; asm volatile("v_cvt_pk_bf16_f32 %0, %1, %2" : "=v"(r) : "v"(lo), "v"(hi)); return r; }

template <class Epi, class Sched, bool FP8 = false, bool ALIGN_EPI = PG8_ALIGN_DEFAULT, bool SP2 = PG8_SP2_DEFAULT>
__device__ __forceinline__ void gemm_phase(PG8_LAS unsigned char* lds, const Gemm g, const Sched& S, const Epi& E) {
    int tid_ = threadIdx.x; asm volatile("" : "+v"(tid_));
    const int tid = tid_, wid = __builtin_amdgcn_readfirstlane(tid >> 6), lane = tid & 63, wr = wid >> 2, wc = wid & 3, fr = lane & 15, fq = lane >> 4;
    const int K = FP8 ? (g.K >> 1) : g.K, nt = K / BK;
    unsigned voffA[2], voffB[2];
#pragma unroll
    for (int i = 0; i < 2; ++i) { int R, C; stage_rc(tid * 16 + i * 8192, R, C); const int Rb = Epi::PERM ? ((R & ~31) + perm32(R & 31)) : R;
        voffA[i] = (unsigned)(R * K + C) * 2u; voffB[i] = (unsigned)(Rb * g.bdil * K + C) * 2u; }
    const size_t kstep = (size_t)(BK * 2);
    const size_t hstep = (size_t)HALF * K * 2;
    const size_t tstep = 2 * hstep;
    const size_t hstepB = hstep * (size_t)g.bdil; const int bL = 4096 / g.bdil;
#define PG8_BTILE(pn) ((const char*)g.Bt + (size_t)((((pn) * 256) & ~4095) + (((pn) * 256) & 4095) / bL + g.bdil * ((((pn) * 256) & 4095) % bL)) * (size_t)(K * 2))
    const unsigned ldsw = (unsigned)wid * 1024u;
    const int aoff = lds_byte(wr * 64 + fr, fq * 8), boff = lds_byte(wc * 32 + fr, fq * 8);
#define PG8_SA(b, h) (((b) * 2 + (h)) * HTB)
#define PG8_SB(b, h) ((4 + (b) * 2 + (h)) * HTB)
#define PG8_STAGE(bufoff, gbase, voff) do { _Pragma("unroll") for (int _i = 0; _i < 2; ++_i) \
        __builtin_amdgcn_global_load_lds((const unsigned*)((const char*)(gbase) + (voff)[_i]), (PG8_LAS unsigned*)(lds + (bufoff) + ldsw + _i * 8192), 16, 0, 0); } while (0)
#define PG8_LDA(dst, b, h) do { _Pragma("unroll") for (int m = 0; m < 4; ++m) _Pragma("unroll") for (int k = 0; k < 2; ++k) dst[m][k] = *(const PG8_LAS bf16x8*)(lds + PG8_SA(b, h) + aoff + m * 2048 + k * 1024); } while (0)
#define PG8_LDB(dst, b, h) do { _Pragma("unroll") for (int n = 0; n < 2; ++n) _Pragma("unroll") for (int k = 0; k < 2; ++k) dst[n][k] = *(const PG8_LAS bf16x8*)(lds + PG8_SB(b, h) + boff + n * 2048 + k * 1024); } while (0)
#define PG8_MMA(ai, bj, At, Bt) do { __builtin_amdgcn_s_setprio(1); _Pragma("unroll") for (int m = 0; m < 4; ++m) _Pragma("unroll") for (int n = 0; n < 2; ++n) { \
        if (FP8) { typedef int i32x4v __attribute__((ext_vector_type(4))); typedef int i32x8v __attribute__((ext_vector_type(8))); \
            const i32x4v b0_ = __builtin_bit_cast(i32x4v, Bt[n][0]), b1_ = __builtin_bit_cast(i32x4v, Bt[n][1]), a0_ = __builtin_bit_cast(i32x4v, At[m][0]), a1_ = __builtin_bit_cast(i32x4v, At[m][1]); \
            const i32x8v b8_ = {b0_[0], b0_[1], b0_[2], b0_[3], b1_[0], b1_[1], b1_[2], b1_[3]}, a8_ = {a0_[0], a0_[1], a0_[2], a0_[3], a1_[0], a1_[1], a1_[2], a1_[3]}; \
            asm volatile("v_mfma_f32_16x16x128_f8f6f4 %0, %1, %2, %0" : "+v"(acc[ai][bj][m][n]) : "v"(b8_), "v"(a8_)); } \
        else { _Pragma("unroll") for (int k = 0; k < 2; ++k) acc[ai][bj][m][n] = __builtin_amdgcn_mfma_f32_16x16x32_bf16(Bt[n][k], At[m][k], acc[ai][bj][m][n], 0, 0, 0); } } \
        __builtin_amdgcn_s_setprio(0); } while (0)
#define PG8_WAIT_V(n) asm volatile("s_waitcnt vmcnt(" #n ")" ::: "memory")
#define PG8_WAIT_L(n) asm volatile("s_waitcnt lgkmcnt(" #n ")" ::: "memory")
#define PG8_BAR __builtin_amdgcn_s_barrier()
#define PG8_SCHED __builtin_amdgcn_sched_barrier(0)
    Unit cur, nxt; int ui = 0;
    if (!S.next(0, cur)) return;
    const int unit_scale = 0x7f7f7f7f;
    f32x4 acc[2][2][4][2];
#pragma unroll
    for (int a = 0; a < 2; ++a)
#pragma unroll
        for (int b = 0; b < 2; ++b)
#pragma unroll
            for (int m = 0; m < 4; ++m)
#pragma unroll
                for (int n = 0; n < 2; ++n) acc[a][b][m][n] = (f32x4){0.f, 0.f, 0.f, 0.f};
    bf16x8 At[4][2], B0[2][2], B1[2][2];
    const char* cA = (const char*)g.A + (size_t)cur.pm * tstep; const char* cB = PG8_BTILE(cur.pn);
    S.a_ready(cur);
    if constexpr (SP2) {
        PG8_STAGE(PG8_SB(0, 0), cB, voffB); PG8_STAGE(PG8_SB(0, 1), cB + hstepB, voffB); PG8_STAGE(PG8_SA(0, 0), cA, voffA); PG8_STAGE(PG8_SA(0, 1), cA + hstep, voffA);
        if (wr == 1) PG8_BAR;
        PG8_WAIT_V(2); PG8_BAR;
        PG8_STAGE(PG8_SB(1, 0), cB + kstep, voffB); PG8_STAGE(PG8_SA(1, 0), cA + kstep, voffA); PG8_STAGE(PG8_SB(1, 1), cB + hstepB + kstep, voffB);
        PG8_WAIT_V(6); PG8_BAR;
    } else {
    PG8_STAGE(PG8_SB(0, 0), cB, voffB); PG8_STAGE(PG8_SA(0, 0), cA, voffA); PG8_STAGE(PG8_SB(0, 1), cB + hstepB, voffB); PG8_STAGE(PG8_SA(0, 1), cA + hstep, voffA);
    if (wr == 1) PG8_BAR;
    PG8_WAIT_V(4); PG8_BAR;
    PG8_STAGE(PG8_SB(1, 0), cB + kstep, voffB); PG8_STAGE(PG8_SA(1, 0), cA + kstep, voffA); PG8_STAGE(PG8_SB(1, 1), cB + hstepB + kstep, voffB);
    PG8_WAIT_V(6); PG8_BAR;
    }
    for (;;) {
        const bool has_next = S.next(ui + 1, nxt);
        const char* nA = has_next ? (const char*)g.A + (size_t)nxt.pm * tstep : cA; const char* nB = has_next ? PG8_BTILE(nxt.pn) : cB;
        for (int t = 0; t < nt; t += 2) {
            const bool last = (t == nt - 2);
            const char* a1 = cA + (size_t)(t + 1) * kstep;
            const char* a2 = last ? nA : cA + (size_t)(t + 2) * kstep; const char* b2 = last ? nB : cB + (size_t)(t + 2) * kstep;
            const char* a3 = a2 + kstep; const char* b3 = b2 + kstep;
            if (last && has_next) S.a_ready(nxt);
            if constexpr (SP2) {
            PG8_LDB(B0, 0, 0); PG8_LDB(B1, 0, 1); PG8_SCHED; PG8_LDA(At, 0, 0); PG8_STAGE(PG8_SA(1, 1), a1 + hstep, voffA);
            PG8_WAIT_V(8); PG8_WAIT_L(0); PG8_BAR; PG8_MMA(0, 0, At, B0); PG8_MMA(0, 1, At, B1); PG8_BAR; PG8_SCHED;
            PG8_LDA(At, 0, 1); PG8_STAGE(PG8_SB(0, 0), b2, voffB); PG8_STAGE(PG8_SB(0, 1), b2 + hstepB, voffB); PG8_STAGE(PG8_SA(0, 0), a2, voffA);
            PG8_WAIT_V(8); PG8_WAIT_L(0); PG8_BAR; PG8_MMA(1, 0, At, B0); PG8_MMA(1, 1, At, B1); PG8_BAR; PG8_SCHED;
            PG8_LDB(B0, 1, 0); PG8_LDB(B1, 1, 1); PG8_SCHED; PG8_LDA(At, 1, 0); PG8_STAGE(PG8_SA(0, 1), a2 + hstep, voffA);
            PG8_WAIT_V(8); PG8_WAIT_L(0); PG8_BAR; PG8_MMA(0, 0, At, B0); PG8_MMA(0, 1, At, B1); PG8_BAR; PG8_SCHED;
            PG8_LDA(At, 1, 1); PG8_STAGE(PG8_SB(1, 0), b3, voffB); PG8_STAGE(PG8_SB(1, 1), b3 + hstepB, voffB); PG8_STAGE(PG8_SA(1, 0), a3, voffA);
            PG8_WAIT_V(8); PG8_WAIT_L(0); PG8_BAR; PG8_MMA(1, 0, At, B0); PG8_MMA(1, 1, At, B1); PG8_BAR; PG8_SCHED;
            } else {
            PG8_LDB(B0, 0, 0); PG8_SCHED; PG8_LDA(At, 0, 0); PG8_STAGE(PG8_SA(1, 1), a1 + hstep, voffA);
            PG8_WAIT_L(8); PG8_BAR; PG8_WAIT_L(0); PG8_MMA(0, 0, At, B0); PG8_BAR; PG8_SCHED;
            PG8_LDB(B1, 0, 1); PG8_STAGE(PG8_SB(0, 0), b2, voffB);
            PG8_BAR; PG8_WAIT_L(0); PG8_MMA(0, 1, At, B1); PG8_BAR;
            PG8_LDA(At, 0, 1); PG8_STAGE(PG8_SA(0, 0), a2, voffA);
            PG8_BAR; PG8_WAIT_L(0); PG8_MMA(1, 0, At, B0); PG8_BAR; PG8_SCHED;
            PG8_STAGE(PG8_SB(0, 1), b2 + hstepB, voffB);
            PG8_WAIT_V(6); PG8_BAR; PG8_MMA(1, 1, At, B1); PG8_BAR;
            PG8_LDB(B0, 1, 0); PG8_SCHED; PG8_LDA(At, 1, 0); PG8_STAGE(PG8_SA(0, 1), a2 + hstep, voffA);
            PG8_WAIT_L(8); PG8_BAR; PG8_WAIT_L(0); PG8_MMA(0, 0, At, B0); PG8_BAR; PG8_SCHED;
            PG8_LDB(B1, 1, 1); PG8_STAGE(PG8_SB(1, 0), b3, voffB);
            PG8_BAR; PG8_WAIT_L(0); PG8_MMA(0, 1, At, B1); PG8_BAR;
            PG8_LDA(At, 1, 1); PG8_STAGE(PG8_SA(1, 0), a3, voffA);
            PG8_BAR; PG8_WAIT_L(0); PG8_MMA(1, 0, At, B0); PG8_BAR; PG8_SCHED;
            PG8_STAGE(PG8_SB(1, 1), b3 + hstepB, voffB);
            PG8_WAIT_V(6); PG8_BAR; PG8_MMA(1, 1, At, B1); PG8_BAR;
            }
        }
        if constexpr (ALIGN_EPI) { if (wr == 0) PG8_BAR; }
        E(acc, cur, wr, wc, fr, fq); S.done(cur);
        if (!has_next) break;
#pragma unroll
        for (int a = 0; a < 2; ++a)
#pragma unroll
            for (int b = 0; b < 2; ++b)
#pragma unroll
                for (int m = 0; m < 4; ++m)
#pragma unroll
                    for (int n = 0; n < 2; ++n) acc[a][b][m][n] = (f32x4){0.f, 0.f, 0.f, 0.f};
        cur = nxt; cA = nA; cB = nB; ++ui;
        if constexpr (ALIGN_EPI) { if (wr == 1) PG8_BAR; }
    }
    PG8_WAIT_V(0);
    if constexpr (!ALIGN_EPI) { if (wr == 0) PG8_BAR; }
    PG8_BAR;
#undef PG8_BTILE
#undef PG8_SA
#undef PG8_SB
#undef PG8_STAGE
#undef PG8_LDA
#undef PG8_LDB
#undef PG8_MMA
#undef PG8_WAIT_V
#undef PG8_WAIT_L
#undef PG8_BAR
#undef PG8_SCHED
}

struct EpiBf16 {
    static constexpr bool PERM = true;
    bf16_t* O; const float* cscale; const float* rscale; int ldc, pad; int blk = 0;
    __device__ __forceinline__ void operator()(const f32x4 (&acc)[2][2][4][2], const Unit& u, int wr, int wc, int fr, int fq) const {
        const int row0 = u.pm * BM + wr * 64 + fr, col0 = u.pn * BM + wc * 32 + 8 * fq;
        f32x4 cs[2][2];
#pragma unroll
        for (int bj = 0; bj < 2; ++bj)
#pragma unroll
            for (int n = 0; n < 2; ++n) cs[bj][n] = cscale ? *(const f32x4*)(cscale + col0 + bj * HALF + 4 * n) : (f32x4){1.f, 1.f, 1.f, 1.f};
        float rsv[2][4];
#pragma unroll
        for (int ai = 0; ai < 2; ++ai)
#pragma unroll
            for (int m = 0; m < 4; ++m) rsv[ai][m] = rscale ? rscale[row0 + ai * HALF + m * 16] : 1.0f;
#pragma unroll
        for (int ai = 0; ai < 2; ++ai)
#pragma unroll
            for (int m = 0; m < 4; ++m) { const int r = row0 + ai * HALF + m * 16; bf16_t* rowp = O + (size_t)r * ldc + col0; const float rs = rsv[ai][m];
#pragma unroll
                for (int bj = 0; bj < 2; ++bj) {
                    const f32x4 v0 = acc[ai][bj][m][0] * cs[bj][0] * rs, v1 = acc[ai][bj][m][1] * cs[bj][1] * rs;
                    u32x4 w; w.x = cvt_pk_bf16(v0[0], v0[1]); w.y = cvt_pk_bf16(v0[2], v0[3]); w.z = cvt_pk_bf16(v1[0], v1[1]); w.w = cvt_pk_bf16(v1[2], v1[3]);
                    bf16_t* dst = blk ? O + (size_t)((col0 + bj * HALF) >> 5) * 16384 + (size_t)r * 32 + ((col0 + bj * HALF) & 31) : rowp + bj * HALF;
                    *(u32x4*)dst = w; } }
    }
};
struct EpiF32 {
    static constexpr bool PERM = true;
    _Float16* C; int ldc, pad; const float* cscale = nullptr;
    __device__ __forceinline__ void operator()(const f32x4 (&acc)[2][2][4][2], const Unit& u, int wr, int wc, int fr, int fq) const {
        typedef _Float16 f16x4 __attribute__((ext_vector_type(4)));
        const int row0 = u.pm * BM + wr * 64 + fr;
#pragma unroll
        for (int ai = 0; ai < 2; ++ai)
#pragma unroll
            for (int m = 0; m < 4; ++m) { const int r = row0 + ai * HALF + m * 16; _Float16* gp = C + (size_t)(r >> 2) * 8192 + (r & 3) * 4;
#pragma unroll
                for (int bj = 0; bj < 2; ++bj)
#pragma unroll
                    for (int n = 0; n < 2; ++n) { const int hp = 2 * u.pn + bj, nch = wc * 8 + 2 * fq + n; f32x4 a = acc[ai][bj][m][n];
                        if (cscale) a = a * *(const f32x4*)(cscale + u.pn * BM + bj * HALF + wc * 32 + 8 * fq + 4 * n);
                        const f16x4 hv = {(_Float16)a[0], (_Float16)a[1], (_Float16)a[2], (_Float16)a[3]};
                        *(f16x4*)(gp + (nch * 16 + hp) * 16) = hv; } }
    }
};
template <bool WQ>
struct EpiResT {
    static constexpr bool PERM = true;
    const bf16_t* R; bf16_t* Yb; const float* cscale; int ldc; float alpha; float* part; unsigned char* Yq = nullptr;
    __device__ __forceinline__ void operator()(const f32x4 (&acc)[2][2][4][2], const Unit& u, int wr, int wc, int fr, int fq) const {
        const int row0 = u.pm * BM + wr * 64 + fr, col0 = u.pn * BM + wc * 32 + 8 * fq;
        f32x4 cs[2][2];
#pragma unroll
        for (int bj = 0; bj < 2; ++bj)
#pragma unroll
            for (int n = 0; n < 2; ++n) cs[bj][n] = cscale ? *(const f32x4*)(cscale + col0 + bj * HALF + 4 * n) : (f32x4){1.f, 1.f, 1.f, 1.f};
#pragma unroll
        for (int ai = 0; ai < 2; ++ai) {
            u32x4 rv[4][2];
#pragma unroll
            for (int m = 0; m < 4; ++m)
#pragma unroll
                for (int bj = 0; bj < 2; ++bj) rv[m][bj] = *(const u32x4*)(R + (size_t)(row0 + ai * HALF + m * 16) * ldc + col0 + bj * HALF);
#pragma unroll
            for (int m = 0; m < 4; ++m) { const size_t off = (size_t)(row0 + ai * HALF + m * 16) * ldc + col0; float ps = 0.f, pq = 0.f;
#pragma unroll
                for (int bj = 0; bj < 2; ++bj) { const u32x4 r = rv[m][bj];
                    const f32x4 r0 = {__uint_as_float(r.x << 16), __uint_as_float(r.x & 0xffff0000u), __uint_as_float(r.y << 16), __uint_as_float(r.y & 0xffff0000u)};
                    const f32x4 r1 = {__uint_as_float(r.z << 16), __uint_as_float(r.z & 0xffff0000u), __uint_as_float(r.w << 16), __uint_as_float(r.w & 0xffff0000u)};
                    const f32x4 y0 = r0 * alpha + acc[ai][bj][m][0] * cs[bj][0], y1 = r1 * alpha + acc[ai][bj][m][1] * cs[bj][1];
                    u32x4 w; w.x = cvt_pk_bf16(y0[0], y0[1]); w.y = cvt_pk_bf16(y0[2], y0[3]); w.z = cvt_pk_bf16(y1[0], y1[1]); w.w = cvt_pk_bf16(y1[2], y1[3]);
                    *(u32x4*)(Yb + off + bj * HALF) = w;
                    if (WQ) { uint2 q8; q8.x = pk4_fp8(y0[0], y0[1], y0[2], y0[3]); q8.y = pk4_fp8(y1[0], y1[1], y1[2], y1[3]); *(uint2*)(Yq + off + bj * HALF) = q8; }
                    ps += ((y0[0] + y0[1]) + (y0[2] + y0[3])) + ((y1[0] + y1[1]) + (y1[2] + y1[3]));
                    pq += ((y0[0] * y0[0] + y0[1] * y0[1]) + (y0[2] * y0[2] + y0[3] * y0[3])) + ((y1[0] * y1[0] + y1[1] * y1[1]) + (y1[2] * y1[2] + y1[3] * y1[3])); }
                ps += __shfl_xor(ps, 16); pq += __shfl_xor(pq, 16); ps += __shfl_xor(ps, 32); pq += __shfl_xor(pq, 32);
                if (fq == 0) { float2 o; o.x = ps; o.y = pq; *(float2*)(part + ((size_t)(row0 + ai * HALF + m * 16) * 32 + u.pn * 4 + wc) * 2) = o; } }
            asm volatile("" ::: "memory");
        }
    }
};
}
#define XB_TMO      128
#define XB_XCNT(j)  (256  + 64 * (j))
#define XB_XSUB(j)  (1280 + 64 * (j))
#define XB_XGEN(j)  (2304 + 64 * (j))
#define XB_TOP      3328
#define XB_TOPGEN   3392
#define XCD_BAR_WORDS 3456
#define XB_SPIN_CAP (1u << 22)
#define LAS __attribute__((address_space(3)))

__device__ __forceinline__ unsigned xb_ld(unsigned* p)              { return __hip_atomic_load(p, __ATOMIC_RELAXED, __HIP_MEMORY_SCOPE_AGENT); }
__device__ __forceinline__ unsigned xb_add(unsigned* p, unsigned v) { return __hip_atomic_fetch_add(p, v, __ATOMIC_RELAXED, __HIP_MEMORY_SCOPE_AGENT); }
__device__ __forceinline__ unsigned xb_xcc_id() { return (unsigned)__builtin_amdgcn_s_getreg((3 << 11) | 20) & 0xFu; }
#define XB_SPIN(cond, bar) do { unsigned _sp = 0; while (cond) { __builtin_amdgcn_s_sleep(1); \
    if ((++_sp & 255u) == 0u) { if (xb_ld(&(bar)[XB_TMO])) break; if (_sp > XB_SPIN_CAP) { atomicAdd(&(bar)[XB_TMO], 1u); break; } } } } while (0)

struct XcdBarrier {
    unsigned* bar; unsigned x;
    volatile LAS unsigned* st;
};

__device__ __forceinline__ XcdBarrier xcd_barrier_post(unsigned* bar, volatile LAS unsigned* st) {
    XcdBarrier b; b.bar = bar; b.x = xb_xcc_id(); b.st = st;
    if (threadIdx.x == 0) (void)xb_add(&bar[XB_XCNT(b.x)], 1u);
    return b;
}
__device__ __forceinline__ void xcd_barrier_complete(unsigned* bar, unsigned x, unsigned& nloc, unsigned& nx) {
    const unsigned G = gridDim.x * gridDim.y * gridDim.z;
    unsigned sum, cnt, mine, sp = 0u;
    for (;;) {
        sum = 0u; cnt = 0u; mine = 0u;
#pragma unroll
        for (unsigned j = 0; j < 16; ++j) { const unsigned c = xb_ld(&bar[XB_XCNT(j)]); sum += c; cnt += (c > 0u) ? 1u : 0u; mine = (j == x) ? c : mine; }
        if (sum == G) break;
        __builtin_amdgcn_s_sleep(1);
        if ((++sp & 255u) == 0u) { if (xb_ld(&bar[XB_TMO])) break; if (sp > XB_SPIN_CAP) { atomicAdd(&bar[XB_TMO], 1u); break; } }
    }
    nloc = mine > 0u ? mine : 1u; nx = cnt > 0u ? cnt : 1u;
}

__device__ __forceinline__ void xcd_barrier(const XcdBarrier& b) {
    asm volatile("s_waitcnt vmcnt(0)" ::: "memory");
    __syncthreads();
    if (threadIdx.x == 0) {
        unsigned* bar = b.bar; unsigned bx = b.x; asm volatile("" : "+s"(bar), "+s"(bx));
        __builtin_amdgcn_s_waitcnt(0);
        unsigned nloc = b.st[0], nx = b.st[1];
        if (nloc == 0u) { xcd_barrier_complete(bar, bx, nloc, nx); b.st[0] = nloc; b.st[1] = nx; }
        const unsigned old = xb_add(&bar[XB_XSUB(bx)], 1u);
        const unsigned gen = old / nloc;
        if (old + 1u == (gen + 1u) * nloc) {
            __builtin_amdgcn_fence(__ATOMIC_RELEASE, "agent");
            asm volatile("s_waitcnt vmcnt(0)" ::: "memory");
            const unsigned og = xb_add(&bar[XB_TOP], 1u);
            const unsigned tg = og / nx;
            if (og + 1u == (tg + 1u) * nx) xb_add(&bar[XB_TOPGEN], 1u);
            else XB_SPIN(xb_ld(&bar[XB_TOPGEN]) == tg, bar);
            __builtin_amdgcn_fence(__ATOMIC_ACQUIRE, "agent");
            xb_add(&bar[XB_XGEN(bx)], 1u);
            asm volatile("s_waitcnt vmcnt(0)" ::: "memory");
        } else {
            XB_SPIN(xb_ld(&bar[XB_XGEN(bx)]) == gen, bar);
            __builtin_amdgcn_fence(__ATOMIC_ACQUIRE, "agent");
            asm volatile("s_waitcnt vmcnt(0)" ::: "memory");
        }
    }
    __syncthreads();
}
using pg8::bf16_t;
constexpr int DM = 2048, NB_ = 8, SEQ = 4096, NT = NB_ * SEQ, DEPTH = 4, NMEM = 256, HD = 128;
constexpr int LOCALW = 1536, MEMW = 512, NEXP = 16384;
constexpr float ALPHA = 1.6817928305074290861f;
constexpr float LN_EPS = 1e-5f;
constexpr float QSCALE = 0.08838834764831845f;
constexpr int NTHR = 512, NWAVE = 8;
constexpr int KVLD = 2048 + 128, VTLD = NT + 128;

__device__ __forceinline__ unsigned pk_bf16(float lo, float hi) { unsigned r; asm volatile("v_cvt_pk_bf16_f32 %0, %1, %2" : "=v"(r) : "v"(lo), "v"(hi)); return r; }
__device__ __forceinline__ float bf_lo(unsigned x) { return __uint_as_float(x << 16); }
__device__ __forceinline__ float bf_hi(unsigned x) { return __uint_as_float(x & 0xffff0000u); }
__device__ __forceinline__ float clamp448(float v) { return __builtin_amdgcn_fmed3f(v, -448.0f, 448.0f); }
__device__ __forceinline__ unsigned pk4_e4m3(float a, float b, float c, float d) {
    int r = __builtin_amdgcn_cvt_pk_fp8_f32(clamp448(a), clamp448(b), 0, false); r = __builtin_amdgcn_cvt_pk_fp8_f32(clamp448(c), clamp448(d), r, true); return (unsigned)r; }
__device__ __forceinline__ float wave_sum(float v) {
#pragma unroll
    for (int o = 32; o >= 1; o >>= 1) v += __shfl_xor(v, o);
    return v;
}

__device__ __forceinline__ int otid() { int t = threadIdx.x; asm volatile("" : "+v"(t)); return t; }
__device__ __forceinline__ int obid() { int b = blockIdx.x; asm volatile("" : "+s"(b)); return b; }

struct Params {
    const float *x, *mem, *w_in_a, *w_pool, *s_pool, *w_in_b, *w_mem_kv, *w_o, *ln_g, *ln_b, *peer_wq, *peer_keys, *peer_u, *peer_v;
    float* out; unsigned* bar; float* part; unsigned char* yq; unsigned char* wq_s; float* sc_s;
    bf16_t *wt_in0, *wt_in1, *wt_in2, *wt_in3, *wt_k, *wt_v, *wt_o, *wt_s, *membf, *kmat, *vtm, *xbf, *h, *vtd, *mix;
    bf16_t* xres;
    unsigned char *xq, *mixq, *wq_in0, *wq_in1, *wq_in2, *wq_in3, *wq_o; float *sc_in, *sc_o;
    float *pcs, *pbw, *cs, *bw;
    unsigned char *U8, *V8;
};

__device__ __forceinline__ void cvt_phase(const float* src, bf16_t* dst, size_t n8) {
    const int tid = otid(), bid = obid();
    for (size_t i = (size_t)bid * NTHR + tid; i < n8; i += (size_t)gridDim.x * NTHR) {
        const float4 a = ((const float4*)src)[2 * i], b = ((const float4*)src)[2 * i + 1];
        uint4 o; o.x = pk_bf16(a.x, a.y); o.y = pk_bf16(a.z, a.w); o.z = pk_bf16(b.x, b.y); o.w = pk_bf16(b.z, b.w);
        ((uint4*)dst)[i] = o;
    }
}
__device__ __forceinline__ void cvt8_phase(const float* src, unsigned char* dst, size_t n16) {
    const int tid = otid(), bid = obid();
    for (size_t i = (size_t)bid * NTHR + tid; i < n16; i += (size_t)gridDim.x * NTHR) {
        const float4 a = ((const float4*)src)[4 * i], b = ((const float4*)src)[4 * i + 1], c = ((const float4*)src)[4 * i + 2], d = ((const float4*)src)[4 * i + 3];
        uint4 o; o.x = pk4_e4m3(a.x, a.y, a.z, a.w); o.y = pk4_e4m3(b.x, b.y, b.z, b.w); o.z = pk4_e4m3(c.x, c.y, c.z, c.w); o.w = pk4_e4m3(d.x, d.y, d.z, d.w);
        ((uint4*)dst)[i] = o;
    }
}
__device__ __forceinline__ void cvt_x_phase(const float* src, unsigned char* d8, bf16_t* d16, size_t n4) {
    const int tid = otid(), bid = obid(); const int lane = tid & 63; const size_t wave = (size_t)bid * NWAVE + (tid >> 6), nw = (size_t)gridDim.x * NWAVE;
    for (size_t w0 = wave * 256; w0 < n4; w0 += nw * 256) {
        float4 v[4];
#pragma unroll
        for (int q = 0; q < 4; ++q) v[q] = ((const float4*)src)[w0 + q * 64 + lane];
#pragma unroll
        for (int q = 0; q < 4; ++q) { const size_t i = w0 + q * 64 + lane;
            ((unsigned*)d8)[i] = pk4_e4m3(v[q].x, v[q].y, v[q].z, v[q].w);
            uint2 o; o.x = pk_bf16(v[q].x, v[q].y); o.y = pk_bf16(v[q].z, v[q].w); ((uint2*)d16)[i] = o; }
    }
}
__device__ __forceinline__ void wquant_rows(const bf16_t* src, unsigned char* dst, float* sc, int rows) {
    const int tid = otid(), bid = obid(); const int lane = tid & 63; const int wave = bid * NWAVE + (tid >> 6), nw = gridDim.x * NWAVE;
    for (int row = wave; row < rows; row += nw) {
        uint4 v[4]; float am = 0.f;
#pragma unroll
        for (int c = 0; c < 4; ++c) { v[c] = *(const uint4*)(src + (size_t)row * DM + c * 512 + lane * 8);
            am = fmaxf(am, fmaxf(fmaxf(fmaxf(fabsf(bf_lo(v[c].x)), fabsf(bf_hi(v[c].x))), fmaxf(fabsf(bf_lo(v[c].y)), fabsf(bf_hi(v[c].y)))), fmaxf(fmaxf(fabsf(bf_lo(v[c].z)), fabsf(bf_hi(v[c].z))), fmaxf(fabsf(bf_lo(v[c].w)), fabsf(bf_hi(v[c].w)))))); }
#pragma unroll
        for (int o = 32; o >= 1; o >>= 1) am = fmaxf(am, __shfl_xor(am, o));
        const float s = am > 0.f ? 448.0f / am : 1.0f;
#pragma unroll
        for (int c = 0; c < 4; ++c) { uint2 o; o.x = pk4_e4m3(bf_lo(v[c].x) * s, bf_hi(v[c].x) * s, bf_lo(v[c].y) * s, bf_hi(v[c].y) * s); o.y = pk4_e4m3(bf_lo(v[c].z) * s, bf_hi(v[c].z) * s, bf_lo(v[c].w) * s, bf_hi(v[c].w) * s);
            *(uint2*)(dst + (size_t)row * DM + c * 512 + lane * 8) = o; }
        if (lane == 0) sc[row] = am > 0.f ? am * (1.0f / 448.0f) : 1.0f;
    }
}
__device__ __forceinline__ void transpose_tile(const float* src, int lds_, bf16_t* dst, int ldd, int k0, int n0, LAS float* tile  ) {
    const int tid = otid(); const int tx = tid & 63, ty = tid >> 6;
    for (int r = ty; r < 64; r += NWAVE) tile[r * 65 + tx] = src[(size_t)(k0 + r) * lds_ + n0 + tx];
    __syncthreads();
    for (int r = ty; r < 64; r += NWAVE) dst[(size_t)(n0 + r) * ldd + k0 + tx] = (bf16_t)(pk_bf16(tile[tx * 65 + r], 0.f) & 0xffffu);
    __syncthreads();
}
template <bool B_NMAJOR>
__device__ __forceinline__ void fold_tile(const float* A, int lda, const float* Bm, const float* scale, bf16_t* Out, int NB, int KI, int grp, int n0, int k0, LAS float* sm,
                                          const float* kscale, const float* kbias, float* pcs, float* pbw) {
    LAS float* As = sm;
    LAS float* Bs = sm + 64 * 33;
    const int tid = otid(), tx = tid & 15, ty = tid >> 4;
    float acc[4][4];
#pragma unroll
    for (int a = 0; a < 4; ++a)
#pragma unroll
        for (int b = 0; b < 4; ++b) acc[a][b] = 0.f;
    const float* Bg = Bm + (size_t)grp * NB * KI;
    float ra[4], rb[8];
#define FOLD_FETCH(I0) do { _Pragma("unroll") for (int u = 0; u < 4; ++u) { const int e = tid + u * NTHR, r = e >> 5, c = e & 31; ra[u] = A[(size_t)(k0 + r) * lda + grp * KI + (I0) + c]; } \
        _Pragma("unroll") for (int u = 0; u < 8; ++u) { const int e = tid + u * NTHR; \
            if (!B_NMAJOR) { const int r = e >> 7, c = e & 127; rb[u] = Bg[(size_t)((I0) + r) * NB + n0 + c]; } \
            else { const int c = e >> 5, r = e & 31; rb[u] = Bg[(size_t)(n0 + c) * KI + (I0) + r]; } } } while (0)
#define FOLD_PUT() do { _Pragma("unroll") for (int u = 0; u < 4; ++u) { const int e = tid + u * NTHR, r = e >> 5, c = e & 31; As[r * 33 + c] = ra[u]; } \
        _Pragma("unroll") for (int u = 0; u < 8; ++u) { const int e = tid + u * NTHR; \
            if (!B_NMAJOR) { const int r = e >> 7, c = e & 127; Bs[r * 129 + c] = rb[u]; } else { const int c = e >> 5, r = e & 31; Bs[r * 129 + c] = rb[u]; } } } while (0)
    FOLD_FETCH(0);
    for (int i0 = 0; i0 < KI; i0 += 32) {
        FOLD_PUT();
        __syncthreads();
        if (i0 + 32 < KI) FOLD_FETCH(i0 + 32);
#pragma unroll 8
        for (int i = 0; i < 32; ++i) {
            float a[4], b[4];
#pragma unroll
            for (int q = 0; q < 4; ++q) { a[q] = As[(tx * 4 + q) * 33 + i]; b[q] = Bs[i * 129 + ty * 4 + q]; }
#pragma unroll
            for (int nn = 0; nn < 4; ++nn)
#pragma unroll
                for (int kk = 0; kk < 4; ++kk) acc[nn][kk] += b[nn] * a[kk];
        }
        __syncthreads();
    }
#undef FOLD_FETCH
#undef FOLD_PUT
    float g4[4] = {1.f, 1.f, 1.f, 1.f}, b4[4] = {0.f, 0.f, 0.f, 0.f};
    if (kscale) {
#pragma unroll
        for (int kk = 0; kk < 4; ++kk) { g4[kk] = kscale[k0 + tx * 4 + kk]; b4[kk] = kbias[k0 + tx * 4 + kk]; } }
#pragma unroll
    for (int nn = 0; nn < 4; ++nn) {
        const int n = n0 + ty * 4 + nn; const float s = scale ? scale[grp * NB + n] : 1.0f;
        uint2 o; o.x = pk_bf16(acc[nn][0] * s * g4[0], acc[nn][1] * s * g4[1]); o.y = pk_bf16(acc[nn][2] * s * g4[2], acc[nn][3] * s * g4[3]);
        *(uint2*)(Out + (size_t)(grp * NB + n) * DM + k0 + tx * 4) = o;
        if (kscale) {
            float c = (bf_lo(o.x) + bf_hi(o.x)) + (bf_lo(o.y) + bf_hi(o.y));
            float w = (acc[nn][0] * b4[0] + acc[nn][1] * b4[1]) + (acc[nn][2] * b4[2] + acc[nn][3] * b4[3]);
#pragma unroll
            for (int of = 8; of >= 1; of >>= 1) { c += __shfl_xor(c, of); w += __shfl_xor(w, of); }
            if (tx == 0) { pcs[(size_t)(grp * NB + n) * 32 + (k0 >> 6)] = c; pbw[(size_t)(grp * NB + n) * 32 + (k0 >> 6)] = w * s; }
        }
    }
}

__device__ __forceinline__ void split_bf16x8(const float (&v)[8], pg8::bf16x8& hi, pg8::bf16x8& lo) {
    unsigned h[4], l[4];
#pragma unroll
    for (int j = 0; j < 4; ++j) { h[j] = pk_bf16(v[2 * j], v[2 * j + 1]); l[j] = pk_bf16(v[2 * j] - bf_lo(h[j]), v[2 * j + 1] - bf_hi(h[j])); }
    typedef unsigned u32x4s __attribute__((ext_vector_type(4)));
    hi = __builtin_bit_cast(pg8::bf16x8, (u32x4s){h[0], h[1], h[2], h[3]}); lo = __builtin_bit_cast(pg8::bf16x8, (u32x4s){l[0], l[1], l[2], l[3]});
}
template <bool B_NMAJOR>
__device__ __forceinline__ void fold_tile_mfma(const float* A, int lda, const float* Bm, const float* scale, bf16_t* Out, int NB, int KI, int grp, int n0, int k0,
                                               const float* kscale, const float* kbias, float* pcs, float* pbw) {
    const int tid = otid(), lane = tid & 63, w = tid >> 6, fr = lane & 15, fq = lane >> 4;
    const float* Bg = Bm + (size_t)grp * NB * KI;
    const int n = n0 + w * 16 + fr;
    pg8::f32x4 acc[4];
#pragma unroll
    for (int rt = 0; rt < 4; ++rt) acc[rt] = (pg8::f32x4){0.f, 0.f, 0.f, 0.f};
#pragma unroll 4
    for (int i0 = 0; i0 < KI; i0 += 32) {
        float bv[8];
        if (B_NMAJOR) { const float4 t0 = *(const float4*)(Bg + (size_t)n * KI + i0 + 8 * fq), t1 = *(const float4*)(Bg + (size_t)n * KI + i0 + 8 * fq + 4);
            bv[0] = t0.x; bv[1] = t0.y; bv[2] = t0.z; bv[3] = t0.w; bv[4] = t1.x; bv[5] = t1.y; bv[6] = t1.z; bv[7] = t1.w; }
        else {
#pragma unroll
            for (int j = 0; j < 8; ++j) bv[j] = Bg[(size_t)(i0 + 8 * fq + j) * NB + n]; }
        float av[4][8];
#pragma unroll
        for (int rt = 0; rt < 4; ++rt) { const float* ap = A + (size_t)(k0 + 16 * rt + fr) * lda + grp * KI + i0 + 8 * fq; const float4 t0 = *(const float4*)ap, t1 = *(const float4*)(ap + 4);
            av[rt][0] = t0.x; av[rt][1] = t0.y; av[rt][2] = t0.z; av[rt][3] = t0.w; av[rt][4] = t1.x; av[rt][5] = t1.y; av[rt][6] = t1.z; av[rt][7] = t1.w; }
        pg8::bf16x8 bh, bl; split_bf16x8(bv, bh, bl);
#pragma unroll
        for (int rt = 0; rt < 4; ++rt) { pg8::bf16x8 ah, al; split_bf16x8(av[rt], ah, al);
            acc[rt] = __builtin_amdgcn_mfma_f32_16x16x32_bf16(ah, bh, acc[rt], 0, 0, 0);
            acc[rt] = __builtin_amdgcn_mfma_f32_16x16x32_bf16(ah, bl, acc[rt], 0, 0, 0);
            acc[rt] = __builtin_amdgcn_mfma_f32_16x16x32_bf16(al, bh, acc[rt], 0, 0, 0); }
    }
    const float s = scale ? scale[grp * NB + n] : 1.0f;
    float c = 0.f, wsum = 0.f;
#pragma unroll
    for (int rt = 0; rt < 4; ++rt) {
        float g4[4] = {1.f, 1.f, 1.f, 1.f}, b4[4] = {0.f, 0.f, 0.f, 0.f};
        if (kscale) {
#pragma unroll
            for (int kk = 0; kk < 4; ++kk) { g4[kk] = kscale[k0 + 16 * rt + 4 * fq + kk]; b4[kk] = kbias[k0 + 16 * rt + 4 * fq + kk]; } }
        uint2 o; o.x = pk_bf16(acc[rt][0] * s * g4[0], acc[rt][1] * s * g4[1]); o.y = pk_bf16(acc[rt][2] * s * g4[2], acc[rt][3] * s * g4[3]);
        *(uint2*)(Out + (size_t)(grp * NB + n) * DM + k0 + 16 * rt + 4 * fq) = o;
        c += (bf_lo(o.x) + bf_hi(o.x)) + (bf_lo(o.y) + bf_hi(o.y));
        wsum += (acc[rt][0] * b4[0] + acc[rt][1] * b4[1]) + (acc[rt][2] * b4[2] + acc[rt][3] * b4[3]);
    }
    if (kscale) {
        c += __shfl_xor(c, 16); wsum += __shfl_xor(wsum, 16); c += __shfl_xor(c, 32); wsum += __shfl_xor(wsum, 32);
        if (fq == 0) { pcs[(size_t)(grp * NB + n) * 32 + (k0 >> 6)] = c; pbw[(size_t)(grp * NB + n) * 32 + (k0 >> 6)] = wsum * s; }
    }
}
template <bool B_NMAJOR>
__device__ __forceinline__ void fold_tile_lds(const float* A, int lda, const float* Bm, const float* scale, bf16_t* Out, int NB, int KI, int grp, int n0, int k0, LAS unsigned char* sm,
                                              const float* kscale, const float* kbias, float* pcs, float* pbw) {
    constexpr int FP = 272;
    LAS unsigned char* Ah = sm; LAS unsigned char* Al = sm + 64 * FP; LAS unsigned char* Bh = sm + 128 * FP; LAS unsigned char* Bl = sm + 256 * FP;
    const int tid = otid(), lane = tid & 63, w = tid >> 6, fr = lane & 15, fq = lane >> 4;
    const float* Bg = Bm + (size_t)grp * NB * KI;
    const int n = n0 + w * 16 + fr;
    pg8::f32x4 acc[4];
#pragma unroll
    for (int rt = 0; rt < 4; ++rt) acc[rt] = (pg8::f32x4){0.f, 0.f, 0.f, 0.f};
    typedef unsigned lu2f __attribute__((ext_vector_type(2)));
#pragma unroll 1
    for (int ic = 0; ic < KI; ic += 128) {
        float4 va[4], vb[8];
#pragma unroll
        for (int u = 0; u < 4; ++u) { const int e = tid + u * NTHR, r = e >> 5, c4 = e & 31; va[u] = *(const float4*)(A + (size_t)(k0 + r) * lda + grp * KI + ic + c4 * 4); }
#pragma unroll
        for (int u = 0; u < 8; ++u) { const int e = tid + u * NTHR, r = e >> 5, c4 = e & 31;
            vb[u] = B_NMAJOR ? *(const float4*)(Bg + (size_t)(n0 + r) * KI + ic + c4 * 4) : *(const float4*)(Bg + (size_t)(ic + r) * NB + n0 + c4 * 4); }
        __builtin_amdgcn_sched_barrier(0);
#pragma unroll
        for (int u = 0; u < 4; ++u) { const int e = tid + u * NTHR, r = e >> 5, c4 = e & 31; const float4 v = va[u];
            const unsigned h0 = pk_bf16(v.x, v.y), h1 = pk_bf16(v.z, v.w), l0 = pk_bf16(v.x - bf_lo(h0), v.y - bf_hi(h0)), l1 = pk_bf16(v.z - bf_lo(h1), v.w - bf_hi(h1));
            *(LAS lu2f*)(Ah + r * FP + c4 * 8) = (lu2f){h0, h1}; *(LAS lu2f*)(Al + r * FP + c4 * 8) = (lu2f){l0, l1}; }
#pragma unroll
        for (int u = 0; u < 8; ++u) { const int e = tid + u * NTHR, r = e >> 5, c4 = e & 31; const float4 v = vb[u];
            const unsigned h0 = pk_bf16(v.x, v.y), h1 = pk_bf16(v.z, v.w), l0 = pk_bf16(v.x - bf_lo(h0), v.y - bf_hi(h0)), l1 = pk_bf16(v.z - bf_lo(h1), v.w - bf_hi(h1));
            if (B_NMAJOR) { *(LAS lu2f*)(Bh + r * FP + c4 * 8) = (lu2f){h0, h1}; *(LAS lu2f*)(Bl + r * FP + c4 * 8) = (lu2f){l0, l1}; }
            else {
                *(LAS unsigned short*)(Bh + (c4 * 4 + 0) * FP + r * 2) = (unsigned short)(h0 & 0xffffu); *(LAS unsigned short*)(Bh + (c4 * 4 + 1) * FP + r * 2) = (unsigned short)(h0 >> 16);
                *(LAS unsigned short*)(Bh + (c4 * 4 + 2) * FP + r * 2) = (unsigned short)(h1 & 0xffffu); *(LAS unsigned short*)(Bh + (c4 * 4 + 3) * FP + r * 2) = (unsigned short)(h1 >> 16);
                *(LAS unsigned short*)(Bl + (c4 * 4 + 0) * FP + r * 2) = (unsigned short)(l0 & 0xffffu); *(LAS unsigned short*)(Bl + (c4 * 4 + 1) * FP + r * 2) = (unsigned short)(l0 >> 16);
                *(LAS unsigned short*)(Bl + (c4 * 4 + 2) * FP + r * 2) = (unsigned short)(l1 & 0xffffu); *(LAS unsigned short*)(Bl + (c4 * 4 + 3) * FP + r * 2) = (unsigned short)(l1 >> 16); } }
        __syncthreads();
#pragma unroll
        for (int ks = 0; ks < 4; ++ks) {
            const pg8::bf16x8 bh = *(const LAS pg8::bf16x8*)(Bh + (w * 16 + fr) * FP + (ks * 32 + 8 * fq) * 2), bl = *(const LAS pg8::bf16x8*)(Bl + (w * 16 + fr) * FP + (ks * 32 + 8 * fq) * 2);
#pragma unroll
            for (int rt = 0; rt < 4; ++rt) {
                const pg8::bf16x8 ah = *(const LAS pg8::bf16x8*)(Ah + (rt * 16 + fr) * FP + (ks * 32 + 8 * fq) * 2), al = *(const LAS pg8::bf16x8*)(Al + (rt * 16 + fr) * FP + (ks * 32 + 8 * fq) * 2);
                acc[rt] = __builtin_amdgcn_mfma_f32_16x16x32_bf16(ah, bh, acc[rt], 0, 0, 0);
                acc[rt] = __builtin_amdgcn_mfma_f32_16x16x32_bf16(ah, bl, acc[rt], 0, 0, 0);
                acc[rt] = __builtin_amdgcn_mfma_f32_16x16x32_bf16(al, bh, acc[rt], 0, 0, 0); }
        }
        __syncthreads();
    }
    const float s = scale ? scale[grp * NB + n] : 1.0f;
    float c = 0.f, wsum = 0.f;
#pragma unroll
    for (int rt = 0; rt < 4; ++rt) {
        float g4[4] = {1.f, 1.f, 1.f, 1.f}, b4[4] = {0.f, 0.f, 0.f, 0.f};
        if (kscale) {
#pragma unroll
            for (int kk = 0; kk < 4; ++kk) { g4[kk] = kscale[k0 + 16 * rt + 4 * fq + kk]; b4[kk] = kbias[k0 + 16 * rt + 4 * fq + kk]; } }
        uint2 o; o.x = pk_bf16(acc[rt][0] * s * g4[0], acc[rt][1] * s * g4[1]); o.y = pk_bf16(acc[rt][2] * s * g4[2], acc[rt][3] * s * g4[3]);
        *(uint2*)(Out + (size_t)(grp * NB + n) * DM + k0 + 16 * rt + 4 * fq) = o;
        c += (bf_lo(o.x) + bf_hi(o.x)) + (bf_lo(o.y) + bf_hi(o.y));
        wsum += (acc[rt][0] * b4[0] + acc[rt][1] * b4[1]) + (acc[rt][2] * b4[2] + acc[rt][3] * b4[3]);
    }
    if (kscale) {
        c += __shfl_xor(c, 16); wsum += __shfl_xor(wsum, 16); c += __shfl_xor(c, 32); wsum += __shfl_xor(wsum, 32);
        if (fq == 0) { pcs[(size_t)(grp * NB + n) * 32 + (k0 >> 6)] = c; pbw[(size_t)(grp * NB + n) * 32 + (k0 >> 6)] = wsum * s; }
    }
}
struct FoldT { const float* A; const float* Bg; const float* scale; bf16_t* Out; const float* kscale; const float* kbias; float* pcs; float* pbw; int NB, KI, grp, n0, k0, nmajor; };
__device__ __forceinline__ void fold_desc(const Params& p, int it, FoldT& d) {
    const size_t WSQ = (size_t)DM * DM;
    if (it < 768) { const int ia = it / 384, r = it % 384, grp = r / 96, r2 = r % 96, ntile = r2 / 32, kt = r2 % 32;
        d.A = p.w_in_a + (size_t)ia * WSQ; d.NB = 384; d.KI = 384; d.Bg = p.w_pool + (size_t)ia * 4 * 384 * 384 + (size_t)grp * 384 * 384; d.scale = p.s_pool + (size_t)ia * LOCALW; d.Out = ia == 0 ? p.wt_in0 : p.wt_in2;
        d.grp = grp; d.n0 = ntile * 128; d.k0 = kt * 64; d.nmajor = 0; d.kscale = nullptr; d.kbias = nullptr; d.pcs = nullptr; d.pbw = nullptr; }
    else { const int j = it - 768, l = j / 512, r = j % 512, grp = r / 32, kt = r % 32;
        d.A = p.peer_wq + (size_t)l * WSQ; d.NB = 128; d.KI = 128; d.Bg = p.peer_keys + (size_t)l * 16 * 128 * 128 + (size_t)grp * 128 * 128; d.scale = nullptr; d.Out = p.wt_s + (size_t)l * WSQ;
        d.grp = grp; d.n0 = 0; d.k0 = kt * 64; d.nmajor = 1; d.kscale = p.ln_g + (size_t)(l * 2) * DM; d.kbias = p.ln_b + (size_t)(l * 2) * DM; d.pcs = p.pcs + (size_t)l * DM * 32; d.pbw = p.pbw + (size_t)l * DM * 32; }
}
__device__ __forceinline__ void fold_stream(const Params& p, LAS unsigned char* sm) {
    constexpr int FP = 272;
    LAS unsigned char* Ah = sm; LAS unsigned char* Al = sm + 64 * FP; LAS unsigned char* Bh = sm + 128 * FP; LAS unsigned char* Bl = sm + 256 * FP;
    const int tid = otid(), lane = tid & 63, w = tid >> 6, fr = lane & 15, fq = lane >> 4; const int G = (int)gridDim.x;
    typedef unsigned lu2f __attribute__((ext_vector_type(2)));
    int it = obid(), ic = 0;
    if (it >= 2816) return;
    FoldT d; fold_desc(p, it, d);
    float4 va[4], vb[8];
#define FS_LOAD(D, IC) do { \
        _Pragma("unroll") for (int u = 0; u < 4; ++u) { const int e = tid + u * NTHR, r = e >> 5, c4 = e & 31; va[u] = *(const float4*)((D).A + (size_t)((D).k0 + r) * DM + (D).grp * (D).KI + (IC) + c4 * 4); } \
        _Pragma("unroll") for (int u = 0; u < 8; ++u) { const int e = tid + u * NTHR; \
            const int r = (D).nmajor ? (e >> 5) : (((e >> 6) & 15) * 8 + (e & 7)), c4 = (D).nmajor ? (e & 31) : ((e >> 10) * 8 + ((e >> 3) & 7)); \
            vb[u] = (D).nmajor ? *(const float4*)((D).Bg + (size_t)((D).n0 + r) * (D).KI + (IC) + c4 * 4) : *(const float4*)((D).Bg + (size_t)((IC) + r) * (D).NB + (D).n0 + c4 * 4); } } while (0)
    FS_LOAD(d, 0);
    pg8::f32x4 acc[4];
#pragma unroll
    for (int rt = 0; rt < 4; ++rt) acc[rt] = (pg8::f32x4){0.f, 0.f, 0.f, 0.f};
#pragma unroll 1
    for (;;) {
        int nit = it, nic = ic + 128; if (nic >= d.KI) { nit = it + G; nic = 0; }
        __builtin_amdgcn_sched_barrier(0);
#pragma unroll
        for (int u = 0; u < 4; ++u) { const int e = tid + u * NTHR, r = e >> 5, c4 = e & 31; const float4 v = va[u];
            const unsigned h0 = pk_bf16(v.x, v.y), h1 = pk_bf16(v.z, v.w), l0 = pk_bf16(v.x - bf_lo(h0), v.y - bf_hi(h0)), l1 = pk_bf16(v.z - bf_lo(h1), v.w - bf_hi(h1));
            *(LAS lu2f*)(Ah + r * FP + c4 * 8) = (lu2f){h0, h1}; *(LAS lu2f*)(Al + r * FP + c4 * 8) = (lu2f){l0, l1}; }
#pragma unroll
        for (int u = 0; u < 8; ++u) { const int e = tid + u * NTHR; const float4 v = vb[u];
            const unsigned h0 = pk_bf16(v.x, v.y), h1 = pk_bf16(v.z, v.w), l0 = pk_bf16(v.x - bf_lo(h0), v.y - bf_hi(h0)), l1 = pk_bf16(v.z - bf_lo(h1), v.w - bf_hi(h1));
            if (d.nmajor) { const int r = e >> 5, c4 = e & 31; *(LAS lu2f*)(Bh + r * FP + c4 * 8) = (lu2f){h0, h1}; *(LAS lu2f*)(Bl + r * FP + c4 * 8) = (lu2f){l0, l1}; }
            else {
                const int r = ((e >> 6) & 15) * 8 + (e & 7), c4 = (e >> 10) * 8 + ((e >> 3) & 7);
                const int cb = ((((r >> 3) ^ ((c4 >> 1) & 3))) << 4) + (r & 7) * 2;
                *(LAS unsigned short*)(Bh + (c4 * 4 + 0) * FP + cb) = (unsigned short)(h0 & 0xffffu); *(LAS unsigned short*)(Bh + (c4 * 4 + 1) * FP + cb) = (unsigned short)(h0 >> 16);
                *(LAS unsigned short*)(Bh + (c4 * 4 + 2) * FP + cb) = (unsigned short)(h1 & 0xffffu); *(LAS unsigned short*)(Bh + (c4 * 4 + 3) * FP + cb) = (unsigned short)(h1 >> 16);
                *(LAS unsigned short*)(Bl + (c4 * 4 + 0) * FP + cb) = (unsigned short)(l0 & 0xffffu); *(LAS unsigned short*)(Bl + (c4 * 4 + 1) * FP + cb) = (unsigned short)(l0 >> 16);
                *(LAS unsigned short*)(Bl + (c4 * 4 + 2) * FP + cb) = (unsigned short)(l1 & 0xffffu); *(LAS unsigned short*)(Bl + (c4 * 4 + 3) * FP + cb) = (unsigned short)(l1 >> 16); } }
        __syncthreads();
        FoldT dn = d; const bool more = nit < 2816;
        if (more) { if (nic == 0) fold_desc(p, nit, dn); FS_LOAD(dn, nic); }
        __builtin_amdgcn_sched_barrier(0);
#pragma unroll
        for (int ks = 0; ks < 4; ++ks) {
            const int bo_ = (w * 16 + fr) * FP + (((ks * 4 + fq) ^ (d.nmajor ? 0 : (((w * 16 + fr) >> 3) & 3))) << 4);
            const pg8::bf16x8 bh = *(const LAS pg8::bf16x8*)(Bh + bo_), bl = *(const LAS pg8::bf16x8*)(Bl + bo_);
#pragma unroll
            for (int rt = 0; rt < 4; ++rt) {
                const pg8::bf16x8 ah = *(const LAS pg8::bf16x8*)(Ah + (rt * 16 + fr) * FP + (ks * 32 + 8 * fq) * 2), al = *(const LAS pg8::bf16x8*)(Al + (rt * 16 + fr) * FP + (ks * 32 + 8 * fq) * 2);
                acc[rt] = __builtin_amdgcn_mfma_f32_16x16x32_bf16(ah, bh, acc[rt], 0, 0, 0);
                acc[rt] = __builtin_amdgcn_mfma_f32_16x16x32_bf16(ah, bl, acc[rt], 0, 0, 0);
                acc[rt] = __builtin_amdgcn_mfma_f32_16x16x32_bf16(al, bh, acc[rt], 0, 0, 0); }
        }
        __syncthreads();
        if (nic == 0) {
            const int n = d.n0 + w * 16 + fr;
            const float s = d.scale ? d.scale[d.grp * d.NB + n] : 1.0f;
            float c = 0.f, wsum = 0.f;
#pragma unroll
            for (int rt = 0; rt < 4; ++rt) {
                float g4[4] = {1.f, 1.f, 1.f, 1.f}, b4[4] = {0.f, 0.f, 0.f, 0.f};
                if (d.kscale) {
#pragma unroll
                    for (int kk = 0; kk < 4; ++kk) { g4[kk] = d.kscale[d.k0 + 16 * rt + 4 * fq + kk]; b4[kk] = d.kbias[d.k0 + 16 * rt + 4 * fq + kk]; } }
                uint2 o; o.x = pk_bf16(acc[rt][0] * s * g4[0], acc[rt][1] * s * g4[1]); o.y = pk_bf16(acc[rt][2] * s * g4[2], acc[rt][3] * s * g4[3]);
                *(uint2*)(d.Out + (size_t)(d.grp * d.NB + n) * DM + d.k0 + 16 * rt + 4 * fq) = o;
                c += (bf_lo(o.x) + bf_hi(o.x)) + (bf_lo(o.y) + bf_hi(o.y));
                wsum += (acc[rt][0] * b4[0] + acc[rt][1] * b4[1]) + (acc[rt][2] * b4[2] + acc[rt][3] * b4[3]);
                acc[rt] = (pg8::f32x4){0.f, 0.f, 0.f, 0.f};
            }
            if (d.kscale) {
                c += __shfl_xor(c, 16); wsum += __shfl_xor(wsum, 16); c += __shfl_xor(c, 32); wsum += __shfl_xor(wsum, 32);
                if (fq == 0) { d.pcs[(size_t)(d.grp * d.NB + n) * 32 + (d.k0 >> 6)] = c; d.pbw[(size_t)(d.grp * d.NB + n) * 32 + (d.k0 >> 6)] = wsum * s; }
            }
        }
        if (!more) break;
        d = dn; it = nit; ic = nic;
    }
#undef FS_LOAD
}
typedef float f32x2 __attribute__((ext_vector_type(2)));
typedef int i32x8p __attribute__((ext_vector_type(8)));
typedef float f32x4p __attribute__((ext_vector_type(4)));
constexpr int ROWB = 1152;
__device__ __forceinline__ float clamp6(float v) { return __builtin_amdgcn_fmed3f(v, -6.0f, 6.0f); }
template <bool GROUPED>
__device__ __forceinline__ void quant_row(const float4 (&v)[8], unsigned char* dst, int row, int lane) {
    float amax = 0.f;
#pragma unroll
    for (int c = 0; c < 8; ++c) amax = fmaxf(amax, fmaxf(fmaxf(fabsf(v[c].x), fabsf(v[c].y)), fmaxf(fabsf(v[c].z), fabsf(v[c].w))));
    unsigned sb;
    if (GROUPED) {
        float g = fmaxf(amax, __shfl_xor(amax, 16)); g = fmaxf(g, __shfl_xor(g, 32));
        sb = pk_bf16(g * (1.0f / 6.0f), 0.f) & 0xffffu;
        float sc = __uint_as_float(sb << 16);
        for (int it = 0; it < 24 && amax <= 3.5f * sc; ++it) { sc *= 0.5f; }
        sb = __float_as_uint(sc) >> 16;
    } else sb = pk_bf16(amax * (1.0f / 6.0f), 0.f) & 0xffffu;
    const float s2 = __uint_as_float(sb << 16);
    const float inv = s2 > 0.f ? 1.0f / s2 : 0.f;
    unsigned q[4];
#pragma unroll
    for (int d = 0; d < 4; ++d) { unsigned r = 0u;
        r = __builtin_amdgcn_cvt_scalef32_pk_fp4_f32(r, clamp6(v[2 * d].x * inv), clamp6(v[2 * d].y * inv), 1.0f, 0);
        r = __builtin_amdgcn_cvt_scalef32_pk_fp4_f32(r, clamp6(v[2 * d].z * inv), clamp6(v[2 * d].w * inv), 1.0f, 1);
        r = __builtin_amdgcn_cvt_scalef32_pk_fp4_f32(r, clamp6(v[2 * d + 1].x * inv), clamp6(v[2 * d + 1].y * inv), 1.0f, 2);
        r = __builtin_amdgcn_cvt_scalef32_pk_fp4_f32(r, clamp6(v[2 * d + 1].z * inv), clamp6(v[2 * d + 1].w * inv), 1.0f, 3);
        q[d] = r; }
    uint4 o; o.x = q[0]; o.y = q[1]; o.z = q[2]; o.w = q[3];
    *(uint4*)(dst + (size_t)row * ROWB + lane * 16) = o;
    *(unsigned short*)(dst + (size_t)row * ROWB + 1024 + lane * 2) = (unsigned short)sb;
}
template <bool GROUPED>
__device__ __forceinline__ void quant_phase(const float* src, unsigned char* dst, int nrows) {
    const int tid = otid(), bid = obid(); const int lane = tid & 63; const int wave = bid * NWAVE + (tid >> 6), nw = gridDim.x * NWAVE;
    for (int row = wave; row < nrows; row += 3 * nw) {
        float4 va[8], vb[8], vc[8];
        const int r1 = row + nw, r2 = row + 2 * nw;
#pragma unroll
        for (int c = 0; c < 8; ++c) va[c] = *(const float4*)(src + (size_t)row * DM + c * 256 + lane * 4);
        if (r1 < nrows) {
#pragma unroll
            for (int c = 0; c < 8; ++c) vb[c] = *(const float4*)(src + (size_t)r1 * DM + c * 256 + lane * 4); }
        if (r2 < nrows) {
#pragma unroll
            for (int c = 0; c < 8; ++c) vc[c] = *(const float4*)(src + (size_t)r2 * DM + c * 256 + lane * 4); }
        __builtin_amdgcn_sched_barrier(0);
        quant_row<GROUPED>(va, dst, row, lane);
        if (r1 < nrows) quant_row<GROUPED>(vb, dst, r1, lane);
        if (r2 < nrows) quant_row<GROUPED>(vc, dst, r2, lane);
    }
}

__device__ __forceinline__ void transpose_wave(const float* src, int lds_, bf16_t* dst, int ldd, int k0, int n0, LAS float* tile, int lane) {
    float4 v[8];
#pragma unroll
    for (int it = 0; it < 8; ++it) v[it] = *(const float4*)(src + (size_t)(k0 + it * 8 + (lane >> 3)) * lds_ + n0 + (lane & 7) * 4);
#pragma unroll
    for (int it = 0; it < 8; ++it) { LAS float* t = tile + (it * 8 + (lane >> 3)) * 33 + (lane & 7) * 4; t[0] = v[it].x; t[1] = v[it].y; t[2] = v[it].z; t[3] = v[it].w; }
    __builtin_amdgcn_fence(__ATOMIC_RELEASE, "wavefront"); __builtin_amdgcn_wave_barrier(); __builtin_amdgcn_fence(__ATOMIC_ACQUIRE, "wavefront");
#pragma unroll
    for (int it = 0; it < 4; ++it) { const int n = it * 8 + (lane >> 3), kc = (lane & 7) * 8; float f[8];
#pragma unroll
        for (int j = 0; j < 8; ++j) f[j] = tile[(kc + j) * 33 + n];
        uint4 o; o.x = pk_bf16(f[0], f[1]); o.y = pk_bf16(f[2], f[3]); o.z = pk_bf16(f[4], f[5]); o.w = pk_bf16(f[6], f[7]);
        *(uint4*)(dst + (size_t)(n0 + n) * ldd + k0 + kc) = o; }
    __builtin_amdgcn_fence(__ATOMIC_RELEASE, "wavefront"); __builtin_amdgcn_wave_barrier(); __builtin_amdgcn_fence(__ATOMIC_ACQUIRE, "wavefront");
}
__device__ __forceinline__ void prologue_phase(const Params& p, LAS unsigned char* lds) {
    const size_t WSQ = (size_t)DM * DM;
    cvt_x_phase(p.x, p.xq, p.xres, (size_t)NT * DM / 4);
    cvt_phase(p.mem, p.membf, (size_t)NB_ * NMEM * DM / 8);
    LAS float* sm = (LAS float*)lds;
    const int bid = obid();
    {
        const int tidw = otid(); const int lanew = tidw & 63, wvw = tidw >> 6;
        LAS float* wt = sm + wvw * (64 * 33);
        for (int it = bid * NWAVE + wvw; it < 23552; it += gridDim.x * NWAVE) {
            if (it < 10240) { const int ib = it / 5120, r = it % 5120, nt = r % 160, kt = r / 160;
                const int n0 = nt * 32, drow = n0 < 3072 ? n0 : (n0 < 4608 ? n0 + 512 : n0 - 1536);
                transpose_wave(p.w_in_b + (size_t)ib * DM * 5120 + n0, 5120, (ib == 0 ? p.wt_in1 : p.wt_in3) + (size_t)drow * DM, DM, kt * 64, 0, wt, lanew); }
            else if (it < 11264) { const int j = it - 10240, ia = j / 512, r = j % 512, nt = r % 16, kt = r / 16;
                transpose_wave(p.w_in_a + (size_t)ia * WSQ + LOCALW, DM, (ia == 0 ? p.wt_in0 : p.wt_in2) + (size_t)LOCALW * DM, DM, kt * 64, nt * 32, wt, lanew); }
            else if (it < 15360) { const int j = it - 11264, l = j / 1024, r = j % 1024, nt = r % 32, kt = r / 32;
                const int n0 = nt * 32; bf16_t* dst = (n0 < 512 ? p.wt_k : p.wt_v) + (size_t)(l * 512 + (n0 & 511)) * DM;
                transpose_wave(p.w_mem_kv + (size_t)l * DM * 1024 + n0, 1024, dst, DM, kt * 64, 0, wt, lanew); }
            else { const int j = it - 15360, l = j / 2048, r = j % 2048, nt = r % 64, kt = r / 64;
                transpose_wave(p.w_o + (size_t)l * WSQ, DM, p.wt_o + (size_t)l * WSQ, DM, kt * 64, nt * 32, wt, lanew); }
        }
        __syncthreads();
    }
    fold_stream(p, lds);
}

__device__ __forceinline__ void pool_add(float (&s)[8], const uint4 v, float sg) {
    s[0] += sg * bf_lo(v.x); s[1] += sg * bf_hi(v.x); s[2] += sg * bf_lo(v.y); s[3] += sg * bf_hi(v.y); s[4] += sg * bf_lo(v.z); s[5] += sg * bf_hi(v.z); s[6] += sg * bf_lo(v.w); s[7] += sg * bf_hi(v.w);
}
__device__ __forceinline__ void pool_phase(const bf16_t* h, unsigned char* mixq) {
    const int tid = otid(), bid = obid();
    for (int item = bid * NTHR + tid; item < NB_ * 64 * 192; item += gridDim.x * NTHR) {
        const int c = (item % 192) * 8, run = (item / 192) & 63, b = item / (192 * 64);
        const int w = 2 << (c / 384), t0 = run * 64;
        const bf16_t* base = h + (size_t)b * SEQ * DM + c;
        float s[8];
#pragma unroll
        for (int j = 0; j < 8; ++j) s[j] = 0.f;
        {
            uint4 wv[16];
#pragma unroll
            for (int i = 1; i <= 16; ++i) { const int t = t0 - i; wv[i - 1] = (i <= w && t >= 0) ? *(const uint4*)(base + (size_t)t * DM) : make_uint4(0u, 0u, 0u, 0u); }
#pragma unroll
            for (int i = 0; i < 16; ++i) pool_add(s, wv[i], 1.0f);
        }
#pragma unroll 1
        for (int tb = 0; tb < 64; tb += 8) {
            uint4 cu[8], ol[8];
#pragma unroll
            for (int j = 0; j < 8; ++j) { const int t = t0 + tb + j; cu[j] = *(const uint4*)(base + (size_t)t * DM);
                ol[j] = (t - w >= 0) ? *(const uint4*)(base + (size_t)(t - w) * DM) : make_uint4(0u, 0u, 0u, 0u); }
#pragma unroll
            for (int j = 0; j < 8; ++j) { const int t = t0 + tb + j;
                pool_add(s, cu[j], 1.0f); pool_add(s, ol[j], -1.0f);
                const float inv = 1.0f / (float)((t + 1) < w ? (t + 1) : w);
                uint2 o;
                o.x = pk4_e4m3(s[0] * inv - bf_lo(cu[j].x), s[1] * inv - bf_hi(cu[j].x), s[2] * inv - bf_lo(cu[j].y), s[3] * inv - bf_hi(cu[j].y));
                o.y = pk4_e4m3(s[4] * inv - bf_lo(cu[j].z), s[5] * inv - bf_hi(cu[j].z), s[6] * inv - bf_lo(cu[j].w), s[7] * inv - bf_hi(cu[j].w));
                *(uint2*)(mixq + ((size_t)b * SEQ + t) * DM + c) = o; }
        }
    }
}

typedef float f32x16 __attribute__((ext_vector_type(16)));
using pg8::bf16x8;
constexpr float SCL2 = QSCALE * 1.4426950408889634f;

typedef unsigned rawv __attribute__((ext_vector_type(4)));
constexpr int KPITCH = 272, VPITCH = 80, WBUF = 10240;
__device__ __forceinline__ void tile_ld_rows(rawv (&raw)[8], const bf16_t* p, size_t ps, int lane) {
    const char* base = (const char*)p; const unsigned off = (unsigned)((size_t)(lane >> 4) * ps + (lane & 15) * 8) * 2u;
#pragma unroll
    for (int i = 0; i < 8; ++i) raw[i] = *(const rawv*)(base + (size_t)(4 * i) * ps * 2 + off);
}
__device__ __forceinline__ void tile_st_rows(const rawv (&raw)[8], LAS unsigned char* wb, int lane) {
#pragma unroll
    for (int i = 0; i < 8; ++i) *(LAS rawv*)(wb + (4 * i + (lane >> 4)) * KPITCH + (lane & 15) * 16) = raw[i];
}
__device__ __forceinline__ void tile_ld_vt(rawv (&raw)[8], const bf16_t* p, size_t ps, int lane) {
    const char* base = (const char*)p; const unsigned off = (unsigned)((size_t)(lane >> 2) * ps + (lane & 3) * 8) * 2u;
#pragma unroll
    for (int i = 0; i < 8; ++i) raw[i] = *(const rawv*)(base + (size_t)(16 * i) * ps * 2 + off);
}
__device__ __forceinline__ void tile_st_vt(const rawv (&raw)[8], LAS unsigned char* wb, int lane) {
#pragma unroll
    for (int i = 0; i < 8; ++i) *(LAS rawv*)(wb + (16 * i + (lane >> 2)) * VPITCH + (lane & 3) * 16) = raw[i];
}
#define ATT_WSYNC() do { __builtin_amdgcn_fence(__ATOMIC_RELEASE, "wavefront"); __builtin_amdgcn_wave_barrier(); __builtin_amdgcn_fence(__ATOMIC_ACQUIRE, "wavefront"); } while (0)

template <int NTL, bool FIRST>
__device__ __forceinline__ void attn_chunk(const bf16x8 (&qf)[8], const bf16_t* kptr, size_t ks, const bf16_t* vtptr, size_t vs,
                                           int t_lo, bool mask0, bool maskL, float& m, float& l, f32x16 (&o)[4], int lane, LAS unsigned char* wb) {
    const int c = lane & 31, hf = lane >> 5;
    const int krow = (c & 0x13) | ((c & 4) << 1) | ((c & 8) >> 1);
    constexpr int RN = (FIRST && NTL <= 4) ? 2 : 1;
    f32x16 S[NTL];
    {
        rawv raw[RN][8];
#define ATT_KT(T) (kptr + (size_t)((((T) >= t_lo ? (T) : t_lo)) * 32) * ks)
#pragma unroll
        for (int t = 0; t < RN; ++t) if (t < NTL) tile_ld_rows(raw[t], ATT_KT(t), ks, lane);
        __builtin_amdgcn_sched_barrier(0);
#pragma unroll
        for (int t = 0; t < NTL; ++t) {
            tile_st_rows(raw[t % RN], wb, lane);
            ATT_WSYNC();
            __builtin_amdgcn_sched_barrier(0);
            if (t + RN < NTL) tile_ld_rows(raw[t % RN], ATT_KT(t + RN), ks, lane);
            __builtin_amdgcn_sched_barrier(0);
#pragma unroll
            for (int v = 0; v < 16; ++v) S[t][v] = 0.f;
#pragma unroll
            for (int s4 = 0; s4 < 8; s4 += 4) {
                bf16x8 kf[4];
#pragma unroll
                for (int s = 0; s < 4; ++s) kf[s] = *(const LAS bf16x8*)(wb + krow * KPITCH + (s4 + s) * 32 + hf * 16);
#pragma unroll
                for (int s = 0; s < 4; ++s) S[t] = __builtin_amdgcn_mfma_f32_32x32x16_bf16(kf[s], qf[s4 + s], S[t], 0, 0, 0);
                __builtin_amdgcn_sched_barrier(0);
            }
            ATT_WSYNC();
            __builtin_amdgcn_sched_barrier(0);
        }
#undef ATT_KT
    }
    float mx = -__builtin_inff();
#pragma unroll
    for (int t = 0; t < NTL; ++t) {
        const bool on = t >= t_lo;
#pragma unroll
        for (int v = 0; v < 16; ++v) {
            const int a = 16 * (v >> 3) + 8 * hf + (v & 7);
            float s = S[t][v] * SCL2;
            bool keep = on;
            if (t == 0) keep = keep && !(mask0 && a < c);
            if (t == NTL - 1) keep = keep && !(maskL && a > c);
            s = keep ? s : -__builtin_inff();
            S[t][v] = s; mx = fmaxf(mx, s);
        }
    }
    mx = fmaxf(mx, __shfl_xor(mx, 32));
    const float mn = FIRST ? mx : fmaxf(m, mx);
    if (FIRST) {
        l = 0.f;
#pragma unroll
        for (int dt = 0; dt < 4; ++dt)
#pragma unroll
            for (int v = 0; v < 16; ++v) o[dt][v] = 0.f;
    } else {
        const float corr = __builtin_amdgcn_exp2f(m - mn);
        l *= corr;
#pragma unroll
        for (int dt = 0; dt < 4; ++dt)
#pragma unroll
            for (int v = 0; v < 16; ++v) o[dt][v] *= corr;
    }
    m = mn;
    typedef unsigned u32x4v __attribute__((ext_vector_type(4)));
    u32x4v P[NTL][2]; float ps = 0.f;
#pragma unroll
    for (int t = 0; t < NTL; ++t) {
        float p[16];
#pragma unroll
        for (int v = 0; v < 16; ++v) { p[v] = __builtin_amdgcn_exp2f(S[t][v] - mn); ps += p[v]; }
#pragma unroll
        for (int s = 0; s < 2; ++s) { P[t][s].x = pk_bf16(p[8 * s + 0], p[8 * s + 1]); P[t][s].y = pk_bf16(p[8 * s + 2], p[8 * s + 3]); P[t][s].z = pk_bf16(p[8 * s + 4], p[8 * s + 5]); P[t][s].w = pk_bf16(p[8 * s + 6], p[8 * s + 7]); }
    }
    l += ps;
    {
        constexpr int VN = NTL <= 4 ? 2 : 1;
        rawv raw[VN][8];
#define ATT_VT(T) (vtptr + (size_t)(((T) >= t_lo ? (T) : t_lo)) * 16384)
#pragma unroll
        for (int t = 0; t < VN; ++t) if (t < NTL) tile_ld_vt(raw[t], ATT_VT(t), vs, lane);
        __builtin_amdgcn_sched_barrier(0);
#pragma unroll
        for (int t = 0; t < NTL; ++t) {
            tile_st_vt(raw[t % VN], wb, lane);
            ATT_WSYNC();
            __builtin_amdgcn_sched_barrier(0);
            if (t + VN < NTL) tile_ld_vt(raw[t % VN], ATT_VT(t + VN), vs, lane);
            __builtin_amdgcn_sched_barrier(0);
#pragma unroll
            for (int s = 0; s < 2; ++s) { const bf16x8 pf = __builtin_bit_cast(bf16x8, P[t][s]);
                bf16x8 vf[4];
#pragma unroll
                for (int dt = 0; dt < 4; ++dt) vf[dt] = *(const LAS bf16x8*)(wb + (dt * 32 + c) * VPITCH + s * 32 + hf * 16);
#pragma unroll
                for (int dt = 0; dt < 4; ++dt) o[dt] = __builtin_amdgcn_mfma_f32_32x32x16_bf16(vf[dt], pf, o[dt], 0, 0, 0); }
            ATT_WSYNC();
            __builtin_amdgcn_sched_barrier(0);
        }
#undef ATT_VT
    }
}
__device__ __forceinline__ void attn_load_q(bf16x8 (&qf)[8], const bf16_t* q, size_t qs, int lane, LAS unsigned char* wb) {
    rawv raw[8]; tile_ld_rows(raw, q, qs, lane);
    tile_st_rows(raw, wb, lane);
    ATT_WSYNC();
#pragma unroll
    for (int s = 0; s < 8; ++s) qf[s] = *(const LAS bf16x8*)(wb + (lane & 31) * KPITCH + s * 32 + (lane >> 5) * 16);
    ATT_WSYNC();
}
__device__ __forceinline__ float attn_store(const f32x16 (&o)[4], float m, float l, bf16_t* outp, size_t os, int lane, LAS unsigned char* wb) {
    const int c = lane & 31, hf = lane >> 5;
    const float lt = l + __shfl_xor(l, 32), inv = 1.0f / lt;
    typedef unsigned lu2s __attribute__((ext_vector_type(2)));
#pragma unroll
    for (int dt = 0; dt < 4; ++dt)
#pragma unroll
        for (int i = 0; i < 4; ++i) {
            lu2s w; w[0] = pk_bf16(o[dt][4 * i + 0] * inv, o[dt][4 * i + 1] * inv); w[1] = pk_bf16(o[dt][4 * i + 2] * inv, o[dt][4 * i + 3] * inv);
            *(LAS lu2s*)(wb + c * KPITCH + (dt * 32 + 8 * i + 4 * hf) * 2) = w;
        }
    ATT_WSYNC();
#pragma unroll
    for (int i = 0; i < 8; ++i) { const int r = 4 * i + (lane >> 4); const rawv v = *(const LAS rawv*)(wb + r * KPITCH + (lane & 15) * 16);
        *(rawv*)((char*)outp + (size_t)r * os * 2 + (lane & 15) * 16) = v; }
    ATT_WSYNC();
    return m + __builtin_amdgcn_logf(lt);
}

__device__ __forceinline__ void attn_store_q(const f32x16 (&o)[4], float l, unsigned char* outp, size_t os, int lane, LAS unsigned char* ws) {
    const int c = lane & 31, hf = lane >> 5;
    const float lt = l + __shfl_xor(l, 32), inv = 1.0f / lt;
#pragma unroll
    for (int ps = 0; ps < 2; ++ps) {
        if ((c >> 4) == ps) {
#pragma unroll
            for (int dt = 0; dt < 4; ++dt)
#pragma unroll
                for (int i = 0; i < 4; ++i)
                    *(LAS unsigned*)(ws + (c & 15) * 144 + dt * 32 + 8 * i + 4 * hf) = pk4_e4m3(o[dt][4 * i + 0] * inv, o[dt][4 * i + 1] * inv, o[dt][4 * i + 2] * inv, o[dt][4 * i + 3] * inv);
        }
        ATT_WSYNC();
#pragma unroll
        for (int u = 0; u < 2; ++u) { const int r = u * 8 + (lane >> 3); const rawv v = *(const LAS rawv*)(ws + r * 144 + (lane & 7) * 16);
            *(rawv*)(outp + (size_t)(ps * 16 + r) * os + (lane & 7) * 16) = v; }
        ATT_WSYNC();
    }
}
constexpr int MVPITCH = 528, MEMK_OFF = 6144, MEMV_OFF = MEMK_OFF + 256 * KPITCH, MEM_LDS_END = MEMV_OFF + 128 * MVPITCH;
__device__ __forceinline__ void memattn_fill(const bf16_t* kmat, const bf16_t* vtm, int layer, int b, int hh, LAS unsigned char* lds, int tid) {
    const bf16_t* kp = kmat + (size_t)(b * NMEM) * KVLD + layer * 512 + hh * HD;
    const bf16_t* vp = vtm + (size_t)(layer * 512 + hh * HD) * KVLD + b * NMEM;
    rawv rk[8], rv[8];
#pragma unroll
    for (int i = 0; i < 8; ++i) { const int pc = tid + i * NTHR; rk[i] = *(const rawv*)(kp + (size_t)(pc >> 4) * KVLD + (pc & 15) * 8); }
#pragma unroll
    for (int i = 0; i < 8; ++i) { const int pc = tid + i * NTHR; rv[i] = *(const rawv*)(vp + (size_t)(pc >> 5) * KVLD + (pc & 31) * 8); }
#pragma unroll
    for (int i = 0; i < 8; ++i) { const int pc = tid + i * NTHR; *(LAS rawv*)(lds + MEMK_OFF + (pc >> 4) * KPITCH + (pc & 15) * 16) = rk[i]; }
#pragma unroll
    for (int i = 0; i < 8; ++i) { const int pc = tid + i * NTHR; *(LAS rawv*)(lds + MEMV_OFF + (pc >> 5) * MVPITCH + (pc & 31) * 16) = rv[i]; }
}
template <bool FIRST>
__device__ __forceinline__ void memattn_chunk(const bf16x8 (&qf)[8], int T0, float& m, float& l, f32x16 (&o)[4], int lane, LAS unsigned char* lds) {
    const int c = lane & 31, hf = lane >> 5;
    const int krow = (c & 0x13) | ((c & 4) << 1) | ((c & 8) >> 1);
    f32x16 S[4];
#pragma unroll
    for (int t = 0; t < 4; ++t) {
#pragma unroll
        for (int v = 0; v < 16; ++v) S[t][v] = 0.f;
#pragma unroll
        for (int s4 = 0; s4 < 8; s4 += 4) {
            bf16x8 kf[4];
#pragma unroll
            for (int s = 0; s < 4; ++s) kf[s] = *(const LAS bf16x8*)(lds + MEMK_OFF + ((T0 + t) * 32 + krow) * KPITCH + (s4 + s) * 32 + hf * 16);
#pragma unroll
            for (int s = 0; s < 4; ++s) S[t] = __builtin_amdgcn_mfma_f32_32x32x16_bf16(kf[s], qf[s4 + s], S[t], 0, 0, 0);
        }
    }
    float mx = -__builtin_inff();
#pragma unroll
    for (int t = 0; t < 4; ++t)
#pragma unroll
        for (int v = 0; v < 16; ++v) { S[t][v] *= SCL2; mx = fmaxf(mx, S[t][v]); }
    mx = fmaxf(mx, __shfl_xor(mx, 32));
    const float mn = FIRST ? mx : fmaxf(m, mx);
    if (FIRST) { l = 0.f;
#pragma unroll
        for (int dt = 0; dt < 4; ++dt)
#pragma unroll
            for (int v = 0; v < 16; ++v) o[dt][v] = 0.f;
    } else { const float corr = __builtin_amdgcn_exp2f(m - mn); l *= corr;
#pragma unroll
        for (int dt = 0; dt < 4; ++dt)
#pragma unroll
            for (int v = 0; v < 16; ++v) o[dt][v] *= corr; }
    m = mn;
    float ps = 0.f;
#pragma unroll
    for (int t = 0; t < 4; ++t) {
        float p[16];
#pragma unroll
        for (int v = 0; v < 16; ++v) { p[v] = __builtin_amdgcn_exp2f(S[t][v] - mn); ps += p[v]; }
#pragma unroll
        for (int s = 0; s < 2; ++s) {
            typedef unsigned u32x4v __attribute__((ext_vector_type(4)));
            u32x4v pw; pw.x = pk_bf16(p[8 * s + 0], p[8 * s + 1]); pw.y = pk_bf16(p[8 * s + 2], p[8 * s + 3]); pw.z = pk_bf16(p[8 * s + 4], p[8 * s + 5]); pw.w = pk_bf16(p[8 * s + 6], p[8 * s + 7]);
            const bf16x8 pf = __builtin_bit_cast(bf16x8, pw);
            bf16x8 vf[4];
#pragma unroll
            for (int dt = 0; dt < 4; ++dt) vf[dt] = *(const LAS bf16x8*)(lds + MEMV_OFF + (dt * 32 + c) * MVPITCH + ((T0 + t) * 32 + s * 16 + hf * 8) * 2);
#pragma unroll
            for (int dt = 0; dt < 4; ++dt) o[dt] = __builtin_amdgcn_mfma_f32_32x32x16_bf16(vf[dt], pf, o[dt], 0, 0, 0);
        }
    }
    l += ps;
}
__device__ __forceinline__ void memattn_task(const bf16_t* h, int ldh, int qoff, int tok0, int hh, unsigned char* mixq, int lane, LAS unsigned char* lds, LAS unsigned char* ws) {
    bf16x8 qf[8];
    {
        const char* qb = (const char*)(h + (size_t)tok0 * ldh + qoff + hh * HD);
        rawv raw[8];
#pragma unroll
        for (int i = 0; i < 8; ++i) raw[i] = *(const rawv*)(qb + (size_t)(4 * i + (lane >> 4)) * ldh * 2 + (lane & 15) * 16);
        const int c = lane & 31, hf = lane >> 5;
#pragma unroll
        for (int s = 0; s < 8; ++s) qf[s] = (bf16x8){0, 0, 0, 0, 0, 0, 0, 0};
#pragma unroll
        for (int ps = 0; ps < 4; ++ps) {
            *(LAS rawv*)(ws + (lane >> 4) * KPITCH + (lane & 15) * 16) = raw[2 * ps]; *(LAS rawv*)(ws + (4 + (lane >> 4)) * KPITCH + (lane & 15) * 16) = raw[2 * ps + 1];
            ATT_WSYNC();
#pragma unroll
            for (int s = 0; s < 8; ++s) { const bf16x8 t = *(const LAS bf16x8*)(ws + (c & 7) * KPITCH + s * 32 + hf * 16); if ((c >> 3) == ps) qf[s] = t; }
            ATT_WSYNC();
        }
    }
    float m = -__builtin_inff(), l = 0.f; f32x16 o[4];
    memattn_chunk<true>(qf, 0, m, l, o, lane, lds);
    memattn_chunk<false>(qf, 4, m, l, o, lane, lds);
    attn_store_q(o, l, mixq + (size_t)tok0 * DM + LOCALW + hh * HD, (size_t)DM, lane, ws);
}

template <bool DIL>
__device__ __forceinline__ void attn_phase(const bf16_t* h, int ldh, int qoff, const bf16_t* vtd, const bf16_t* kmat, const bf16_t* vtm, int layer, bf16_t* mix, unsigned char* mixq, LAS unsigned char* lds) {
    const int tid = otid(), bid = obid(); const int lane0 = tid & 63, wv = tid >> 6;
    LAS float* lseb = (LAS float*)lds;
    LAS unsigned char* wb = lds + 6144 + wv * WBUF;
    for (int bt = bid; bt < 256; bt += gridDim.x) {
        const int pi = (bt & 7) * 4 + (bt >> 6), c8 = (bt >> 3) & 7, b = pi >> 2, hh = pi & 3;
        const int tokb = b * SEQ + c8 * 512;
        if (DIL) {
            for (int wt = wv; wt < 48; wt += NWAVE) {
                int lane = lane0; asm volatile("" : "+v"(lane));
                const int g = wt >> 4, idx = wt & 15;
                const int dil = g == 0 ? 1 : (g == 1 ? 4 : 16), Lg = SEQ / dil;
                const int r = g == 0 ? 0 : (g == 1 ? (idx >> 2) : idx), tile = g == 0 ? idx : (g == 1 ? (idx & 3) : 0);
                const int i0 = c8 * (512 / dil) + tile * 32;
                const size_t rs = (size_t)dil * ldh;
                const bf16_t* base = h + (size_t)(b * SEQ + r) * ldh + g * 512 + hh * HD;
                bf16x8 qf[8]; attn_load_q(qf, base + (size_t)i0 * rs, rs, lane, wb);
                const bf16_t* kp = base + LOCALW + (long long)(i0 - 128) * (long long)rs;
                const bf16_t* vp = vtd + (size_t)g * 512 * NT + ((long long)(b * SEQ + r * Lg + i0 - 128) / 32) * 16384 + hh * HD * 32;
                int t_lo = (128 - i0) / 32; t_lo = t_lo < 0 ? 0 : t_lo;
                float m = -__builtin_inff(), l = 0.f; f32x16 o[4];
                attn_chunk<5, true>(qf, kp, rs, vp, (size_t)32, t_lo, true, true, m, l, o, lane, wb);
                const int tl = r + dil * (tile * 32);
                const float lse = attn_store(o, m, l, mix + (size_t)(tokb + tl) * DM + g * 512 + hh * HD, (size_t)dil * DM, lane, wb);
                if (lane < 32) lseb[g * 512 + tl + dil * lane] = lse;
            }
        }
        {
            int tz = tid; asm volatile("" : "+v"(tz));
            __syncthreads();
            memattn_fill(kmat, vtm, layer, b, hh, lds, tz);
            __syncthreads();
            for (int wt = wv; wt < 16; wt += NWAVE) { int lane = lane0; asm volatile("" : "+v"(lane)); memattn_task(h, ldh, qoff, tokb + wt * 32, hh, mixq, lane, lds, lds + MEM_LDS_END + wv * 2304); }
            if (!DIL) __syncthreads();
        }
        if (DIL) {
            asm volatile("s_waitcnt vmcnt(0)" ::: "memory");
            __syncthreads();
            for (int e = tid; e < 512 * 48; e += NTHR) {
                const int tk = e / 48, rem = e % 48, g = rem >> 4, pc = rem & 15;
                const float l0 = lseb[tk], l1 = lseb[512 + tk], l2 = lseb[1024 + tk];
                const float mx = fmaxf(l0, fmaxf(l1, l2));
                const float e0 = __builtin_amdgcn_exp2f(l0 - mx), e1 = __builtin_amdgcn_exp2f(l1 - mx), e2 = __builtin_amdgcn_exp2f(l2 - mx);
                const float al = (g == 0 ? e0 : (g == 1 ? e1 : e2)) / (e0 + e1 + e2);
                const size_t off = (size_t)(tokb + tk) * DM + g * 512 + hh * HD + pc * 8;
                const uint4 v = *(const uint4*)(mix + off);
                uint2 w; w.x = pk4_e4m3(bf_lo(v.x) * al, bf_hi(v.x) * al, bf_lo(v.y) * al, bf_hi(v.y) * al); w.y = pk4_e4m3(bf_lo(v.z) * al, bf_hi(v.z) * al, bf_lo(v.w) * al, bf_hi(v.w) * al);
                *(uint2*)(mixq + off) = w;
            }
            __syncthreads();
        }
    }
}

__device__ __forceinline__ void ln_phase(float* y, const float* gam, const float* bet, bf16_t* xb) {
    const int tid = otid(), bid = obid(); const int lane = tid & 63; const int wave = bid * NWAVE + (tid >> 6), nw = gridDim.x * NWAVE;
    for (int row = wave; row < NT; row += nw) {
        float4 v[8]; float s = 0.f;
#pragma unroll
        for (int c = 0; c < 8; ++c) { v[c] = *(const float4*)(y + (size_t)row * DM + c * 256 + lane * 4); s += (v[c].x + v[c].y) + (v[c].z + v[c].w); }
        const float mean = wave_sum(s) * (1.0f / DM); float q = 0.f;
#pragma unroll
        for (int c = 0; c < 8; ++c) { const float a = v[c].x - mean, b = v[c].y - mean, cc = v[c].z - mean, d = v[c].w - mean; q += (a * a + b * b) + (cc * cc + d * d); }
        const float rstd = rsqrtf(wave_sum(q) * (1.0f / DM) + LN_EPS);
#pragma unroll
        for (int c = 0; c < 8; ++c) {
            const int col = c * 256 + lane * 4; const float4 g4 = *(const float4*)(gam + col), b4 = *(const float4*)(bet + col);
            float4 o; o.x = (v[c].x - mean) * rstd * g4.x + b4.x; o.y = (v[c].y - mean) * rstd * g4.y + b4.y; o.z = (v[c].z - mean) * rstd * g4.z + b4.z; o.w = (v[c].w - mean) * rstd * g4.w + b4.w;
            *(float4*)(y + (size_t)row * DM + col) = o;
            uint2 pk; pk.x = pk_bf16(o.x, o.y); pk.y = pk_bf16(o.z, o.w); *(uint2*)(xb + (size_t)row * DM + col) = pk;
        }
    }
}

__device__ __forceinline__ void tk_insert(float (&L)[16], float x) {
#pragma unroll
    for (int i = 15; i >= 1; --i) L[i] = __builtin_amdgcn_fmed3f(L[i - 1], L[i], x);
    L[0] = fmaxf(L[0], x);
}
#define WAVE_SYNC() do { __builtin_amdgcn_fence(__ATOMIC_RELEASE, "wavefront"); __builtin_amdgcn_wave_barrier(); __builtin_amdgcn_fence(__ATOMIC_ACQUIRE, "wavefront"); } while (0)
__device__ __forceinline__ float dot32_fp4(const f32x2 (&x2)[16], const uint4 u) {
    const unsigned w[4] = {u.x, u.y, u.z, u.w};
    f32x2 p = {0.f, 0.f}, q = {0.f, 0.f};
#pragma unroll
    for (int d = 0; d < 4; ++d) {
        const f32x2 t0 = __builtin_amdgcn_cvt_scalef32_pk_f32_fp4(w[d], 1.0f, 0), t1 = __builtin_amdgcn_cvt_scalef32_pk_f32_fp4(w[d], 1.0f, 1);
        const f32x2 t2 = __builtin_amdgcn_cvt_scalef32_pk_f32_fp4(w[d], 1.0f, 2), t3 = __builtin_amdgcn_cvt_scalef32_pk_f32_fp4(w[d], 1.0f, 3);
        p = x2[4 * d + 0] * t0 + p; q = x2[4 * d + 1] * t1 + q; p = x2[4 * d + 2] * t2 + p; q = x2[4 * d + 3] * t3 + q; }
    p = p + q;
    return p.x + p.y;
}
__device__ __forceinline__ void axpy32_fp4(f32x2 (&acc)[16], float w_, const uint4 u) {
    const unsigned w[4] = {u.x, u.y, u.z, u.w};
    const f32x2 ww = {w_, w_};
#pragma unroll
    for (int d = 0; d < 4; ++d) {
        const f32x2 t0 = __builtin_amdgcn_cvt_scalef32_pk_f32_fp4(w[d], 1.0f, 0), t1 = __builtin_amdgcn_cvt_scalef32_pk_f32_fp4(w[d], 1.0f, 1);
        const f32x2 t2 = __builtin_amdgcn_cvt_scalef32_pk_f32_fp4(w[d], 1.0f, 2), t3 = __builtin_amdgcn_cvt_scalef32_pk_f32_fp4(w[d], 1.0f, 3);
        acc[4 * d + 0] = ww * t0 + acc[4 * d + 0]; acc[4 * d + 1] = ww * t1 + acc[4 * d + 1]; acc[4 * d + 2] = ww * t2 + acc[4 * d + 2]; acc[4 * d + 3] = ww * t3 + acc[4 * d + 3]; }
}
__device__ __forceinline__ float reduce4(float p0, float p1, float p2, float p3, int lane) {
    const bool b5 = (lane & 32) != 0, b4 = (lane & 16) != 0;
    float s0 = b5 ? p2 : p0, s1 = b5 ? p3 : p1; const float t0 = b5 ? p0 : p2, t1 = b5 ? p1 : p3;
    s0 += __shfl_xor(t0, 32); s1 += __shfl_xor(t1, 32);
    float k = b4 ? s1 : s0; const float t = b4 ? s0 : s1; k += __shfl_xor(t, 16);
    k += __shfl_xor(k, 8); k += __shfl_xor(k, 4); k += __shfl_xor(k, 2); k += __shfl_xor(k, 1);
    return k;
}
typedef float lf4v __attribute__((ext_vector_type(4)));
typedef unsigned lu2v __attribute__((ext_vector_type(2)));
__device__ __forceinline__ float4 lds_ld4(const LAS float* p) { const lf4v t = *(const LAS lf4v*)p; return make_float4(t[0], t[1], t[2], t[3]); }
__device__ __forceinline__ void lds_st4(LAS float* p, const float4 v) { *(LAS lf4v*)p = (lf4v){v.x, v.y, v.z, v.w}; }
__device__ __forceinline__ uint2 lds_ldu2(const LAS unsigned short* p) { const lu2v t = *(const LAS lu2v*)p; uint2 r; r.x = t[0]; r.y = t[1]; return r; }
__device__ __forceinline__ void lds_stu2(LAS unsigned short* p, const uint2 v) { *(LAS lu2v*)p = (lu2v){v.x, v.y}; }
__device__ __forceinline__ void peer_phase(const bf16_t* ybf, bf16_t* xres, float* fout, const _Float16* scores, const float* cs, const float* bw, const float* lg1, const float* lb1, const unsigned char* U8, const unsigned char* V8, const float* gam, const float* bet, unsigned char* xq, const float* part, LAS unsigned char* lds) {
    const int tid = otid(), bid = obid(); const int lane = tid & 63, wv = tid >> 6; const int wave = bid * NWAVE + wv, nw = gridDim.x * NWAVE;
    LAS float* vbuf = (LAS float*)(lds + wv * 12544);
    LAS int* ebuf = (LAS int*)(lds + wv * 12544 + 4352);
    LAS float* gbuf = (LAS float*)(lds + wv * 12544 + 6400);
    LAS unsigned short* ybuf = (LAS unsigned short*)(lds + wv * 12544 + 8448);
    LAS float* pl = (LAS float*)(lds + 8 * 12544);
    {
        const float* srcs[6] = {lg1, lb1, gam, bet, cs, bw};
#pragma unroll
        for (int v = 0; v < 6; ++v) lds_st4(pl + v * 2048 + tid * 4, *(const float4*)(srcs[v] + tid * 4));
        __syncthreads();
    }
    for (int tok0 = wave * 4; tok0 < NT; tok0 += nw * 4) {
        float mu4[4], rs4[4];
        {
            const float4 pv = *(const float4*)(part + ((size_t)(tok0 + (lane >> 4)) * 32 + (lane & 15) * 2) * 2);
            float s = pv.x + pv.z, q = pv.y + pv.w;
#pragma unroll
            for (int o = 1; o <= 8; o <<= 1) { s += __shfl_xor(s, o); q += __shfl_xor(q, o); }
            const float mean = s * (1.0f / DM); const float rsd = rsqrtf(fmaxf(q * (1.0f / DM) - mean * mean, 0.f) + LN_EPS);
#pragma unroll
            for (int ti = 0; ti < 4; ++ti) { mu4[ti] = __builtin_bit_cast(float, __builtin_amdgcn_readlane(__builtin_bit_cast(int, mean), ti * 16)); rs4[ti] = __builtin_bit_cast(float, __builtin_amdgcn_readlane(__builtin_bit_cast(int, rsd), ti * 16)); }
        }
        {
            const int tl = lane >> 4;
            const float rs = tl == 0 ? rs4[0] : (tl == 1 ? rs4[1] : (tl == 2 ? rs4[2] : rs4[3]));
            const float nm = -rs * (tl == 0 ? mu4[0] : (tl == 1 ? mu4[1] : (tl == 2 ? mu4[2] : mu4[3])));
            const _Float16* s = scores + (size_t)(tok0 >> 2) * 8192 + ((lane & 15) * 4 + tl) * 4;
            const LAS float* cp = pl + 8192 + (lane & 15) * 4; const LAS float* bp = pl + 10240 + (lane & 15) * 4;
            float L[16];
#pragma unroll
            for (int i = 0; i < 16; ++i) L[i] = -__builtin_inff();
#pragma unroll 1
            for (int n0 = 0; n0 < 128; n0 += 32) {
                float4 sv[8], cv[8], bv[8];
#pragma unroll
                for (int u = 0; u < 8; ++u) { const int nch = (n0 >> 2) + u; { typedef _Float16 f16x4 __attribute__((ext_vector_type(4))); const f16x4 hv = *(const f16x4*)(s + nch * 256); sv[u] = make_float4((float)hv[0], (float)hv[1], (float)hv[2], (float)hv[3]); } cv[u] = lds_ld4(cp + nch * 64); bv[u] = lds_ld4(bp + nch * 64); }
                __builtin_amdgcn_sched_barrier(0);
#pragma unroll
                for (int u = 0; u < 8; ++u) {
                    const int n = n0 + 4 * u; float4 v = sv[u]; const float4 c4 = cv[u], b4 = bv[u];
                    v.x = rs * v.x + (nm * c4.x + b4.x); v.y = rs * v.y + (nm * c4.y + b4.y); v.z = rs * v.z + (nm * c4.z + b4.z); v.w = rs * v.w + (nm * c4.w + b4.w);
                    tk_insert(L, __uint_as_float((__float_as_uint(v.x) & ~127u) | (unsigned)(n + 0)));
                    tk_insert(L, __uint_as_float((__float_as_uint(v.y) & ~127u) | (unsigned)(n + 1)));
                    tk_insert(L, __uint_as_float((__float_as_uint(v.z) & ~127u) | (unsigned)(n + 2)));
                    tk_insert(L, __uint_as_float((__float_as_uint(v.w) & ~127u) | (unsigned)(n + 3)));
                }
            }
#pragma unroll
            for (int i = 0; i < 16; ++i) vbuf[lane * 17 + i] = L[i];
        }
        WAVE_SYNC();
        if (lane < 32) {
            const int b1 = ((lane >> 3) * 16 + 2 * (lane & 7)) * 17, b2 = b1 + 17;
            float v1[16], v2[16], M[16];
#pragma unroll
            for (int i = 0; i < 16; ++i) { v1[i] = vbuf[b1 + i]; v2[i] = vbuf[b2 + i]; M[i] = -__builtin_inff(); }
#pragma unroll
            for (int a = 0; a < 16; ++a)
#pragma unroll
                for (int b = 0; b < 16; ++b)
                    if ((a + 1) * (b + 1) <= 16) tk_insert(M, __uint_as_float((__float_as_uint(v1[a] + v2[b]) & ~255u) | (unsigned)(a * 16 + b)));
            float e[16], sum = 0.f;
#pragma unroll
            for (int k = 0; k < 16; ++k) { e[k] = __expf(M[k] - M[0]); sum += e[k]; }
            const float inv = 1.0f / sum;
#pragma unroll
            for (int k = 0; k < 16; ++k) {
                const unsigned code = __float_as_uint(M[k]) & 255u; const int a = code >> 4, b = code & 15;
                const unsigned i1 = __float_as_uint(vbuf[b1 + a]) & 127u, i2 = __float_as_uint(vbuf[b2 + b]) & 127u;
                ebuf[lane * 16 + k] = (int)(i1 * 128u + i2);
                gbuf[lane * 16 + k] = e[k] * inv;
            }
        }
        WAVE_SYNC();
        for (int ti = 0; ti < 4; ++ti) {
            const int tok = tok0 + ti;
            int ln = lane; asm volatile("" : "+v"(ln));
            unsigned vo16 = (unsigned)ln * 16u, vo2 = (unsigned)ln * 2u; asm volatile("" : "+v"(vo16), "+v"(vo2));
            const int e0 = ebuf[ti * 128 + ln], e1 = ebuf[ti * 128 + 64 + ln]; const float g0 = gbuf[ti * 128 + ln], g1 = gbuf[ti * 128 + 64 + ln];
#define ROW_LOAD(TBL, QB, SB, K0) do { unsigned v16_ = vo16, v2_ = vo2; asm volatile("" : "+v"(v16_), "+v"(v2_)); _Pragma("unroll") for (int j_ = 0; j_ < 8; ++j_) { \
                const int e_ = __builtin_amdgcn_readlane((K0) < 64 ? e0 : e1, ((K0) + j_) & 63); \
                unsigned ro_; asm volatile("s_mul_i32 %0, %1, %2" : "=s"(ro_) : "s"(e_), "s"((int)ROWB));        \
                const unsigned char* r_ = (TBL) + ro_; \
                QB[j_] = *(const uint4*)(r_ + v16_); SB[j_] = *(const unsigned short*)(r_ + v2_ + 1024); } } while (0)
#define U_COMPUTE(QB, SB, K0) do { f32x4p d_[8]; _Pragma("unroll") for (int j_ = 0; j_ < 8; ++j_) { \
                    i32x8p a_; a_[0] = (int)QB[j_].x; a_[1] = (int)QB[j_].y; a_[2] = (int)QB[j_].z; a_[3] = (int)QB[j_].w; a_[4] = 0; a_[5] = 0; a_[6] = 0; a_[7] = 0; \
                    d_[j_] = __builtin_amdgcn_mfma_scale_f32_16x16x128_f8f6f4(a_, xb, (f32x4p){0.f, 0.f, 0.f, 0.f}, 4, 0, 0, (int)((unsigned)SB[j_] >> 7), 0, 0x7f7f7f7f); } \
                __builtin_amdgcn_sched_barrier(0); \
                float pj_[8]; _Pragma("unroll") for (int j_ = 0; j_ < 8; ++j_) { \
                    const float mt_ = __uint_as_float((((unsigned)SB[j_] & 0x7fu) << 16) | 0x3f800000u); \
                    pj_[j_] = (d_[j_][0] * dm0 + d_[j_][1] * dm1 + d_[j_][2] * dm2 + d_[j_][3] * dm3) * mt_; } \
                const float r0_ = reduce4(pj_[0], pj_[1], pj_[2], pj_[3], ln), r1_ = reduce4(pj_[4], pj_[5], pj_[6], pj_[7], ln); \
                _Pragma("unroll") for (int j_ = 0; j_ < 8; ++j_) { \
                    const float aj_ = __builtin_bit_cast(float, __builtin_amdgcn_readlane(__builtin_bit_cast(int, j_ < 4 ? r0_ : r1_), 16 * (j_ & 3))); \
                    if (ln == (((K0) + j_) & 63)) { if ((K0) < 64) a0 = aj_; else a1 = aj_; } } } while (0)
#define V_COMPUTE(QB, SB, K0) do { _Pragma("unroll") for (int j_ = 0; j_ < 8; ++j_) { \
                const float wk_ = __builtin_bit_cast(float, __builtin_amdgcn_readlane(__builtin_bit_cast(int, (K0) < 64 ? w0 : w1), ((K0) + j_) & 63)); \
                axpy32_fp4(acc, wk_ * __uint_as_float((unsigned)SB[j_] << 16), QB[j_]); __builtin_amdgcn_sched_barrier(0); } } while (0)
#define SCHED_FENCE() __builtin_amdgcn_sched_barrier(0)
            float a0 = 0.f, a1 = 0.f;
            uint4 qa[8], qb[8]; unsigned short sa[8], sb2[8];
            ROW_LOAD(U8, qa, sa, 0); SCHED_FENCE();
            i32x8p xb;
            const float dm0 = ((ln & 15) - 4 * (ln >> 4)) == 0 ? 1.f : 0.f, dm1 = ((ln & 15) - 4 * (ln >> 4)) == 1 ? 1.f : 0.f, dm2 = ((ln & 15) - 4 * (ln >> 4)) == 2 ? 1.f : 0.f, dm3 = ((ln & 15) - 4 * (ln >> 4)) == 3 ? 1.f : 0.f;
            {
                const float mu = ti == 0 ? mu4[0] : (ti == 1 ? mu4[1] : (ti == 2 ? mu4[2] : mu4[3])), rs = ti == 0 ? rs4[0] : (ti == 1 ? rs4[1] : (ti == 2 ? rs4[2] : rs4[3]));
                const int xo = (ln & 15) * 4 + ((ln >> 5) & 1) * 64 + ((ln >> 4) & 1) * 1024;
#pragma unroll
                for (int r = 0; r < 8; ++r) { const int of = xo + (r & 3) * 256 + (r >> 2) * 128;
                    const uint2 yv = *(const uint2*)(ybf + (size_t)tok * DM + of); const float4 a = make_float4(bf_lo(yv.x), bf_hi(yv.x), bf_lo(yv.y), bf_hi(yv.y));
                    lds_stu2(ybuf + of, yv);
                    const float4 gg = lds_ld4(pl + of), bb = lds_ld4(pl + 2048 + of);
                    xb[r] = (int)pk4_e4m3((a.x - mu) * rs * gg.x + bb.x, (a.y - mu) * rs * gg.y + bb.y, (a.z - mu) * rs * gg.z + bb.z, (a.w - mu) * rs * gg.w + bb.w); }
            }
#pragma unroll 1
            for (int k = 0; k < 128; k += 16) {
                ROW_LOAD(U8, qb, sb2, k + 8); SCHED_FENCE();
                U_COMPUTE(qa, sa, k); SCHED_FENCE();
                if (k + 16 < 128) ROW_LOAD(U8, qa, sa, k + 16); else ROW_LOAD(V8, qa, sa, 0);
                SCHED_FENCE();
                U_COMPUTE(qb, sb2, k + 8); SCHED_FENCE();
            }
            const float w0 = g0 * 0.5f * a0 * (1.0f + erff(a0 * 0.70710678118654752f)), w1 = g1 * 0.5f * a1 * (1.0f + erff(a1 * 0.70710678118654752f));
            f32x2 acc[16];
#pragma unroll
            for (int i = 0; i < 16; ++i) acc[i] = (f32x2){0.f, 0.f};
#pragma unroll 1
            for (int k = 0; k < 128; k += 16) {
                ROW_LOAD(V8, qb, sb2, k + 8); SCHED_FENCE();
                V_COMPUTE(qa, sa, k); SCHED_FENCE();
                if (k + 16 < 128) { ROW_LOAD(V8, qa, sa, k + 16); }
                SCHED_FENCE();
                V_COMPUTE(qb, sb2, k + 8); SCHED_FENCE();
            }
            float s = 0.f;
            {
                int l2 = ln; asm volatile("" : "+v"(l2));
                const float mu = ti == 0 ? mu4[0] : (ti == 1 ? mu4[1] : (ti == 2 ? mu4[2] : mu4[3])), rs = ti == 0 ? rs4[0] : (ti == 1 ? rs4[1] : (ti == 2 ? rs4[2] : rs4[3]));
#pragma unroll
                for (int c = 0; c < 8; ++c) { const uint2 yv = lds_ldu2(ybuf + c * 256 + l2 * 4); const float4 a = make_float4(bf_lo(yv.x), bf_hi(yv.x), bf_lo(yv.y), bf_hi(yv.y));
                    const float4 gg = lds_ld4(pl + c * 256 + l2 * 4), bb = lds_ld4(pl + 2048 + c * 256 + l2 * 4);
                    acc[c * 2 + 0] += (f32x2){ALPHA * ((a.x - mu) * rs * gg.x + bb.x), ALPHA * ((a.y - mu) * rs * gg.y + bb.y)};
                    acc[c * 2 + 1] += (f32x2){ALPHA * ((a.z - mu) * rs * gg.z + bb.z), ALPHA * ((a.w - mu) * rs * gg.w + bb.w)};
                    s += (acc[c * 2 + 0].x + acc[c * 2 + 0].y) + (acc[c * 2 + 1].x + acc[c * 2 + 1].y); }
            }
            const float mean = wave_sum(s) * (1.0f / DM); float q = 0.f;
#pragma unroll
            for (int i = 0; i < 16; ++i) { const float d0 = acc[i].x - mean, d1 = acc[i].y - mean; q += d0 * d0 + d1 * d1; }
            const float rstd = rsqrtf(wave_sum(q) * (1.0f / DM) + LN_EPS);
#pragma unroll
            for (int c = 0; c < 8; ++c) {
                const int col = c * 256 + ln * 4; const float4 ga = lds_ld4(pl + 4096 + col), ba = lds_ld4(pl + 6144 + col);
                float4 oa; oa.x = (acc[c * 2 + 0].x - mean) * rstd * ga.x + ba.x; oa.y = (acc[c * 2 + 0].y - mean) * rstd * ga.y + ba.y;
                oa.z = (acc[c * 2 + 1].x - mean) * rstd * ga.z + ba.z; oa.w = (acc[c * 2 + 1].y - mean) * rstd * ga.w + ba.w;
                if (fout) *(float4*)(fout + (size_t)tok * DM + col) = oa;
                else { { uint2 xb2; xb2.x = pk_bf16(oa.x, oa.y); xb2.y = pk_bf16(oa.z, oa.w); *(uint2*)(xres + (size_t)tok * DM + col) = xb2; }
                       *(unsigned*)(xq + (size_t)tok * DM + col) = pk4_e4m3(oa.x, oa.y, oa.z, oa.w); }
            }
        }
        WAVE_SYNC();
    }
}


__device__ __forceinline__ void table_slot(const Params& p, int l, int ph) {
    const int lo = ph == 0 ? 0 : (ph == 1 ? 10923 : 21846), hi = ph == 0 ? 10923 : (ph == 1 ? 21846 : 2 * NEXP);
    const int ulo = lo < NEXP ? lo : NEXP, uhi = hi < NEXP ? hi : NEXP, vlo = (lo > NEXP ? lo : NEXP) - NEXP, vhi = (hi > NEXP ? hi : NEXP) - NEXP;
    if (uhi > ulo) quant_phase<true>(p.peer_u + ((size_t)l * NEXP + ulo) * DM, p.U8 + ((size_t)l * NEXP + ulo) * ROWB, uhi - ulo);
    if (vhi > vlo) quant_phase<false>(p.peer_v + ((size_t)l * NEXP + vlo) * DM, p.V8 + ((size_t)l * NEXP + vlo) * ROWB, vhi - vlo);
}
constexpr int FP8_SCORE_FROM = 1;
constexpr int PEER_LDS_END = 8 * 12544 + 6 * 8192;
constexpr int MEM_SCR_END = MEM_LDS_END + 8 * 2304;
constexpr int LDS_MAIN0 = (MEM_SCR_END > pg8::STAGE_BYTES ? MEM_SCR_END : pg8::STAGE_BYTES);
constexpr int LDS_MAIN = LDS_MAIN0 > PEER_LDS_END ? LDS_MAIN0 : PEER_LDS_END;
constexpr int LDS_TOTAL = LDS_MAIN + 16;
__global__ __launch_bounds__(512, 2) void mega(Params p) {
    extern __shared__ __attribute__((aligned(16))) unsigned char shm[];
    LAS unsigned char* lds = (LAS unsigned char*)shm;
    volatile LAS unsigned* xb_words = (volatile LAS unsigned*)(lds + LDS_MAIN);
    if (threadIdx.x < 4) xb_words[threadIdx.x] = 0u;
    __syncthreads();
    XcdBarrier bar = xcd_barrier_post(p.bar, xb_words);
    const size_t WSQ = (size_t)DM * DM;
    const int G = (int)gridDim.x, c = (int)blockIdx.x;

    prologue_phase(p, lds);
    xcd_barrier(bar);
    {
        const int gt = obid() * NTHR + otid();
        if (gt < DEPTH * DM) { float a = 0.f, b = 0.f;
            for (int t = 0; t < 32; ++t) { a += p.pcs[(size_t)gt * 32 + t]; b += p.pbw[(size_t)gt * 32 + t]; }
            const int ly = gt >> 11, col = gt & 2047, hp = col >> 7, n = col & 127, pi = ly * DM + ((n >> 2) * 16 + hp) * 4 + (n & 3);
            p.cs[pi] = a; p.bw[pi] = b; } }
    {
        pg8::Gemm g; g.A = p.membf; g.Bt = p.wt_k; g.M = NB_ * NMEM; g.N = 2048; g.K = DM; g.bdil = 1;
        pg8::StaticOrder S; S.init(g.M, g.N, G, c); pg8::EpiBf16 E; E.O = p.kmat; E.cscale = nullptr; E.rscale = nullptr; E.ldc = KVLD; E.pad = 0;
        pg8::gemm_phase<pg8::EpiBf16, pg8::StaticOrder>(lds, g, S, E);
        g.A = p.wt_v; g.Bt = p.membf; E.O = p.vtm; S.init(g.M, g.N, G, (c + 64) % G);
        pg8::gemm_phase<pg8::EpiBf16, pg8::StaticOrder>(lds, g, S, E); }
    {
        wquant_rows(p.wt_in0, p.wq_in0, p.sc_in + 0 * 5120, 2048); wquant_rows(p.wt_in1, p.wq_in1, p.sc_in + 1 * 5120, 5120);
        wquant_rows(p.wt_in2, p.wq_in2, p.sc_in + 2 * 5120, 2048); wquant_rows(p.wt_in3, p.wq_in3, p.sc_in + 3 * 5120, 5120);
        wquant_rows(p.wt_o, p.wq_o, p.sc_o, DEPTH * DM); wquant_rows(p.wt_s + (size_t)FP8_SCORE_FROM * WSQ, p.wq_s + (size_t)FP8_SCORE_FROM * WSQ, p.sc_s + FP8_SCORE_FROM * DM, (DEPTH - FP8_SCORE_FROM) * DM); }
    xcd_barrier(bar);
    for (int l = 0; l < DEPTH; ++l) {
        const bool pool = (l & 1) == 0; const int ldh = pool ? DM : 3584;
        const unsigned char* wq_in = l == 0 ? p.wq_in0 : (l == 1 ? p.wq_in1 : (l == 2 ? p.wq_in2 : p.wq_in3));
        const float* sc_in = p.sc_in + (size_t)l * 5120;
        const bool late = ((obid() >> 3) & 1) == 0;
        if (!late) table_slot(p, l, 0);
        { pg8::Gemm g; g.A = (const bf16_t*)p.xq; g.Bt = (const bf16_t*)wq_in; g.M = NT; g.N = ldh; g.K = DM; g.bdil = 1;
          pg8::StaticOrder S; S.init(g.M, g.N, G, c); pg8::EpiBf16 E; E.O = p.h; E.cscale = sc_in; E.rscale = nullptr; E.ldc = ldh; E.pad = 0;
          pg8::gemm_phase<pg8::EpiBf16, pg8::StaticOrder, true>(lds, g, S, E);
          if (!pool) {
              for (int gi = 0; gi < 3; ++gi) {
                  g.A = (const bf16_t*)(wq_in + (size_t)(3584 + gi * 512) * DM); g.Bt = (const bf16_t*)p.xq; g.M = 512; g.N = NT; g.bdil = gi == 0 ? 1 : (gi == 1 ? 4 : 16);
                  S.init(g.M, g.N, G, c); E.O = p.vtd + (size_t)gi * 512 * NT; E.cscale = nullptr; E.rscale = sc_in + 3584 + gi * 512; E.ldc = VTLD; E.blk = 1;
                  pg8::gemm_phase<pg8::EpiBf16, pg8::StaticOrder, true>(lds, g, S, E); } } }
        if (late) table_slot(p, l, 0);
        xcd_barrier(bar);
        if (pool) { pool_phase(p.h, p.mixq); attn_phase<false>(p.h, ldh, ldh - MEMW, p.vtd, p.kmat, p.vtm, l, p.mix, p.mixq, lds); }
        else attn_phase<true>(p.h, ldh, ldh - MEMW, p.vtd, p.kmat, p.vtm, l, p.mix, p.mixq, lds);
        xcd_barrier(bar);
        if (!late) table_slot(p, l, 1);
        if (l >= FP8_SCORE_FROM) {
        { pg8::Gemm g; g.A = (const bf16_t*)p.mixq; g.Bt = (const bf16_t*)(p.wq_o + (size_t)l * WSQ); g.M = NT; g.N = DM; g.K = DM; g.bdil = 1;
          pg8::StaticOrder S; S.init(g.M, g.N, G, c); pg8::EpiResT<true> E; E.R = p.xres; E.Yb = p.xbf; E.cscale = p.sc_o + (size_t)l * DM; E.ldc = DM; E.alpha = ALPHA; E.part = p.part; E.Yq = p.yq;
          pg8::gemm_phase<pg8::EpiResT<true>, pg8::StaticOrder, true>(lds, g, S, E); }
        } else {
        { pg8::Gemm g; g.A = (const bf16_t*)p.mixq; g.Bt = (const bf16_t*)(p.wq_o + (size_t)l * WSQ); g.M = NT; g.N = DM; g.K = DM; g.bdil = 1;
          pg8::StaticOrder S; S.init(g.M, g.N, G, c); pg8::EpiResT<false> E; E.R = p.xres; E.Yb = p.xbf; E.cscale = p.sc_o + (size_t)l * DM; E.ldc = DM; E.alpha = ALPHA; E.part = p.part; E.Yq = p.yq;
          pg8::gemm_phase<pg8::EpiResT<false>, pg8::StaticOrder, true>(lds, g, S, E); }
        }
        if (late) table_slot(p, l, 1);
        xcd_barrier(bar);
        if (!late) table_slot(p, l, 2);
        if (l >= FP8_SCORE_FROM) {
        { pg8::Gemm g; g.A = (const bf16_t*)p.yq; g.Bt = (const bf16_t*)(p.wq_s + (size_t)l * WSQ); g.M = NT; g.N = DM; g.K = DM; g.bdil = 1;
          pg8::StaticOrder S; S.init(g.M, g.N, G, c); pg8::EpiF32 E; E.C = (_Float16*)p.h; E.ldc = DM; E.pad = 0; E.cscale = p.sc_s + (size_t)l * DM;
          pg8::gemm_phase<pg8::EpiF32, pg8::StaticOrder, true>(lds, g, S, E); }
        } else {
        { pg8::Gemm g; g.A = p.xbf; g.Bt = p.wt_s + (size_t)l * WSQ; g.M = NT; g.N = DM; g.K = DM; g.bdil = 1;
          pg8::StaticOrder S; S.init(g.M, g.N, G, c); pg8::EpiF32 E; E.C = (_Float16*)p.h; E.ldc = DM; E.pad = 0;
          pg8::gemm_phase<pg8::EpiF32, pg8::StaticOrder>(lds, g, S, E); }
        }
        if (late) table_slot(p, l, 2);
        xcd_barrier(bar);
        peer_phase(p.xbf, p.xres, l == DEPTH - 1 ? p.out : nullptr, (const _Float16*)p.h, p.cs + (size_t)l * DM, p.bw + (size_t)l * DM, p.ln_g + (size_t)(l * 2) * DM, p.ln_b + (size_t)(l * 2) * DM, p.U8 + (size_t)l * NEXP * ROWB, p.V8 + (size_t)l * NEXP * ROWB, p.ln_g + (size_t)(l * 2 + 1) * DM, p.ln_b + (size_t)(l * 2 + 1) * DM, p.xq, p.part, lds);
        xcd_barrier(bar);
    }
}

constexpr size_t MB = 1024ull * 1024ull;
constexpr size_t OFF_WT_IN0 = 1 * MB;
constexpr size_t OFF_WT_IN1 = OFF_WT_IN0 + 8 * MB;
constexpr size_t OFF_WT_IN2 = OFF_WT_IN1 + 20 * MB;
constexpr size_t OFF_WT_IN3 = OFF_WT_IN2 + 8 * MB;
constexpr size_t OFF_WT_KV  = OFF_WT_IN3 + 20 * MB;
constexpr size_t OFF_WT_O   = OFF_WT_KV + 16 * MB;
constexpr size_t OFF_WT_S   = OFF_WT_O + 32 * MB;
constexpr size_t OFF_MEMBF  = OFF_WT_S + 32 * MB;
constexpr size_t OFF_KV     = OFF_MEMBF + 8 * MB;
constexpr size_t OFF_U      = OFF_KV + 18 * MB;
constexpr size_t OFF_V      = OFF_U + 128 * MB;
constexpr size_t OFF_SU     = OFF_V + 128 * MB;
constexpr size_t OFF_SV     = OFF_SU + 1 * MB;
constexpr size_t OFF_XBF    = OFF_SV + 1 * MB;
constexpr size_t OFF_H      = OFF_XBF + 128 * MB;
constexpr size_t OFF_MIX    = OFF_H + 321 * MB;
constexpr size_t OFF_XQ     = OFF_MIX + 128 * MB;
constexpr size_t OFF_MIXQ   = OFF_XQ + 64 * MB;
constexpr size_t OFF_WQ     = OFF_MIXQ + 64 * MB;
constexpr size_t OFF_XRES   = OFF_WQ + 46 * MB;
constexpr size_t OFF_YQ     = OFF_XRES + 128 * MB;
constexpr size_t OFF_WQS    = OFF_YQ + 64 * MB;
constexpr size_t WS_NEED    = OFF_WQS + 17 * MB;

extern "C" void kernel_launch(void* const* d_in, const int* in_sizes, int n_in, void* d_out, int out_size, void* d_ws, size_t ws_size, hipStream_t stream) {
    if (ws_size < WS_NEED) return;
    char* ws = (char*)d_ws;
    Params p{};
    p.x = (const float*)d_in[0]; p.mem = (const float*)d_in[1]; p.w_in_a = (const float*)d_in[2]; p.w_pool = (const float*)d_in[3]; p.s_pool = (const float*)d_in[4];
    p.w_in_b = (const float*)d_in[5]; p.w_mem_kv = (const float*)d_in[6]; p.w_o = (const float*)d_in[7]; p.ln_g = (const float*)d_in[8]; p.ln_b = (const float*)d_in[9];
    p.peer_wq = (const float*)d_in[10]; p.peer_keys = (const float*)d_in[11]; p.peer_u = (const float*)d_in[12]; p.peer_v = (const float*)d_in[13];
    p.out = (float*)d_out; p.bar = (unsigned*)ws;
    p.wt_in0 = (bf16_t*)(ws + OFF_WT_IN0); p.wt_in1 = (bf16_t*)(ws + OFF_WT_IN1); p.wt_in2 = (bf16_t*)(ws + OFF_WT_IN2); p.wt_in3 = (bf16_t*)(ws + OFF_WT_IN3);
    p.wt_k = (bf16_t*)(ws + OFF_WT_KV); p.wt_v = (bf16_t*)(ws + OFF_WT_KV + 8 * MB); p.wt_o = (bf16_t*)(ws + OFF_WT_O); p.wt_s = (bf16_t*)(ws + OFF_WT_S); p.membf = (bf16_t*)(ws + OFF_MEMBF); p.kmat = (bf16_t*)(ws + OFF_KV); p.vtm = (bf16_t*)(ws + OFF_KV + 9 * MB);
    p.pcs = (float*)(ws + OFF_SU); p.pbw = (float*)(ws + OFF_SV); p.cs = (float*)(ws + 65536); p.bw = (float*)(ws + 65536 + 32768);
    p.xres = (bf16_t*)(ws + OFF_XRES);
    p.xq = (unsigned char*)(ws + OFF_XQ); p.mixq = (unsigned char*)(ws + OFF_MIXQ); p.part = (float*)(ws + OFF_H + 160 * MB); p.yq = (unsigned char*)(ws + OFF_YQ); p.wq_s = (unsigned char*)(ws + OFF_WQS); p.sc_s = (float*)(ws + OFF_WQS + 16 * MB);
    p.wq_in0 = (unsigned char*)(ws + OFF_WQ); p.wq_in1 = p.wq_in0 + 4 * MB; p.wq_in2 = p.wq_in1 + 10 * MB; p.wq_in3 = p.wq_in2 + 4 * MB; p.wq_o = p.wq_in3 + 10 * MB;
    p.sc_in = (float*)(ws + OFF_WQ + 44 * MB); p.sc_o = (float*)(ws + OFF_WQ + 45 * MB);
    p.U8 = (unsigned char*)(ws + OFF_U); p.V8 = (unsigned char*)(ws + OFF_V); p.xbf = (bf16_t*)(ws + OFF_XBF); p.h = (bf16_t*)(ws + OFF_H); p.vtd = (bf16_t*)(ws + OFF_H + 224 * MB); p.mix = (bf16_t*)(ws + OFF_MIX);
    static int grid = 0;
    if (!grid) {
        int dev = 0, cus = 0, per_cu = 0;
        hipGetDevice(&dev);
        hipDeviceGetAttribute(&cus, hipDeviceAttributeMultiprocessorCount, dev);
        hipFuncSetAttribute((const void*)mega, hipFuncAttributeMaxDynamicSharedMemorySize, LDS_TOTAL);
        hipOccupancyMaxActiveBlocksPerMultiprocessor(&per_cu, mega, NTHR, LDS_TOTAL);
        grid = cus * (per_cu < 1 ? per_cu : 1);
    }
    if (grid <= 0) return;
    hipMemsetAsync(p.bar, 0, XCD_BAR_WORDS * sizeof(unsigned), stream);
    hipLaunchKernelGGL(mega, dim3(grid), dim3(NTHR), LDS_TOTAL, stream, p);
}
```

```cpp
#include <hip/hip_runtime.h>
#include <stdint.h>
#define PG8_ALIGN_DEFAULT true
#define PG8_SP2_DEFAULT true
namespace pg8 {
#define PG8_LAS __attribute__((address_space(3)))
typedef unsigned short bf16_t;
typedef short bf16x8 __attribute__((ext_vector_type(8)));
typedef float f32x4 __attribute__((ext_vector_type(4)));
typedef unsigned u32x4 __attribute__((ext_vector_type(4)));
constexpr int BM = 256, BK = 64, HALF = 128, HTB = HALF * BK * 2  , STAGE_BYTES = 8 * HTB, NXCD = 8, WGM = 8;

__host__ __device__ __forceinline__ int lds_byte(int r, int c) { const int st = (r >> 4) * 2 + (c >> 5), rr = r & 15, cc = c & 31, ob = rr * 64 + cc * 2; return st * 1024 + (ob ^ (((ob >> 9) & 1) << 5)); }
__host__ __device__ __forceinline__ void stage_rc(int b, int& R, int& C) { const int st = b / 1024, sb = b % 1024, swz = sb ^ (((sb >> 9) & 1) << 5); R = (st >> 1) * 16 + swz / 64; C = (st & 1) * 32 + (swz % 64) / 2; }
__host__ __device__ __forceinline__ int perm32(int rho) { const int n = rho >> 4, i = rho & 15; return 8 * (i >> 2) + 4 * n + (i & 3); }

struct Unit { int pm, pn; };
struct Gemm { const bf16_t* A; const bf16_t* Bt; int M, N, K, bdil; };

struct StaticOrder {
    int nM, nN, nwg, G, c;
    __host__ __device__ void init(int M, int N, int G_, int c_) { nM = M / BM; nN = N / BM; nwg = nM * nN; G = G_; c = c_; }
    __host__ __device__ bool next(int i, Unit& u) const {
        const long L = (long)i * G + c; if (L >= nwg) return false;
        int wgid = (int)L; { const int q = nwg / NXCD, r = nwg % NXCD, xcd = wgid % NXCD, off = wgid / NXCD; wgid = (xcd < r ? xcd * (q + 1) : r * (q + 1) + (xcd - r) * q) + off; }
        const int nig = WGM * nN, gid = wgid / nig, fm = gid * WGM, gsz = (nM - fm) < WGM ? (nM - fm) : WGM;
        u.pm = fm + ((wgid % nig) % gsz); u.pn = (wgid % nig) / gsz; return true;
    }
    __device__ __forceinline__ void a_ready(const Unit&) const {}
    __device__ __forceinline__ void done(const Unit&) const {}
};

__device__ __forceinline__ unsigned pk4_fp8(float a, float b, float c, float d) {
    a = fminf(fmaxf(a, -448.f), 448.f); b = fminf(fmaxf(b, -448.f), 448.f); c = fminf(fmaxf(c, -448.f), 448.f); d = fminf(fmaxf(d, -448.f), 448.f);
    int r = __builtin_amdgcn_cvt_pk_fp8_f32(a, b, 0, false); r = __builtin_amdgcn_cvt_pk_fp8_f32(c, d, r, true); return (unsigned)r; }
__device__ __forceinline__ unsigned cvt_pk_bf16(float lo, float hi) { unsigned r; asm volatile("v_cvt_pk_bf16_f32 %0, %1, %2" : "=v"(r) : "v"(lo), "v"(hi)); return r; }

template <class Epi, class Sched, bool FP8 = false, bool ALIGN_EPI = PG8_ALIGN_DEFAULT, bool SP2 = PG8_SP2_DEFAULT>
__device__ __forceinline__ void gemm_phase(PG8_LAS unsigned char* lds, const Gemm g, const Sched& S, const Epi& E) {
    int tid_ = threadIdx.x; asm volatile("" : "+v"(tid_));
    const int tid = tid_, wid = __builtin_amdgcn_readfirstlane(tid >> 6), lane = tid & 63, wr = wid >> 2, wc = wid & 3, fr = lane & 15, fq = lane >> 4;
    const int K = FP8 ? (g.K >> 1) : g.K, nt = K / BK;
    unsigned voffA[2], voffB[2];
#pragma unroll
    for (int i = 0; i < 2; ++i) { int R, C; stage_rc(tid * 16 + i * 8192, R, C); const int Rb = Epi::PERM ? ((R & ~31) + perm32(R & 31)) : R;
        voffA[i] = (unsigned)(R * K + C) * 2u; voffB[i] = (unsigned)(Rb * g.bdil * K + C) * 2u; }
    const size_t kstep = (size_t)(BK * 2);
    const size_t hstep = (size_t)HALF * K * 2;
    const size_t tstep = 2 * hstep;
    const size_t hstepB = hstep * (size_t)g.bdil; const int bL = 4096 / g.bdil;
#define PG8_BTILE(pn) ((const char*)g.Bt + (size_t)((((pn) * 256) & ~4095) + (((pn) * 256) & 4095) / bL + g.bdil * ((((pn) * 256) & 4095) % bL)) * (size_t)(K * 2))
    const unsigned ldsw = (unsigned)wid * 1024u;
    const int aoff = lds_byte(wr * 64 + fr, fq * 8), boff = lds_byte(wc * 32 + fr, fq * 8);
#define PG8_SA(b, h) (((b) * 2 + (h)) * HTB)
#define PG8_SB(b, h) ((4 + (b) * 2 + (h)) * HTB)
#define PG8_STAGE(bufoff, gbase, voff) do { _Pragma("unroll") for (int _i = 0; _i < 2; ++_i) \
        __builtin_amdgcn_global_load_lds((const unsigned*)((const char*)(gbase) + (voff)[_i]), (PG8_LAS unsigned*)(lds + (bufoff) + ldsw + _i * 8192), 16, 0, 0); } while (0)
#define PG8_LDA(dst, b, h) do { _Pragma("unroll") for (int m = 0; m < 4; ++m) _Pragma("unroll") for (int k = 0; k < 2; ++k) dst[m][k] = *(const PG8_LAS bf16x8*)(lds + PG8_SA(b, h) + aoff + m * 2048 + k * 1024); } while (0)
#define PG8_LDB(dst, b, h) do { _Pragma("unroll") for (int n = 0; n < 2; ++n) _Pragma("unroll") for (int k = 0; k < 2; ++k) dst[n][k] = *(const PG8_LAS bf16x8*)(lds + PG8_SB(b, h) + boff + n * 2048 + k * 1024); } while (0)
#define PG8_MMA(ai, bj, At, Bt) do { __builtin_amdgcn_s_setprio(1); _Pragma("unroll") for (int m = 0; m < 4; ++m) _Pragma("unroll") for (int n = 0; n < 2; ++n) { \
        if (FP8) { typedef int i32x4v __attribute__((ext_vector_type(4))); typedef int i32x8v __attribute__((ext_vector_type(8))); \
            const i32x4v b0_ = __builtin_bit_cast(i32x4v, Bt[n][0]), b1_ = __builtin_bit_cast(i32x4v, Bt[n][1]), a0_ = __builtin_bit_cast(i32x4v, At[m][0]), a1_ = __builtin_bit_cast(i32x4v, At[m][1]); \
            const i32x8v b8_ = {b0_[0], b0_[1], b0_[2], b0_[3], b1_[0], b1_[1], b1_[2], b1_[3]}, a8_ = {a0_[0], a0_[1], a0_[2], a0_[3], a1_[0], a1_[1], a1_[2], a1_[3]}; \
            asm volatile("v_mfma_f32_16x16x128_f8f6f4 %0, %1, %2, %0" : "+v"(acc[ai][bj][m][n]) : "v"(b8_), "v"(a8_)); } \
        else { _Pragma("unroll") for (int k = 0; k < 2; ++k) acc[ai][bj][m][n] = __builtin_amdgcn_mfma_f32_16x16x32_bf16(Bt[n][k], At[m][k], acc[ai][bj][m][n], 0, 0, 0); } } \
        __builtin_amdgcn_s_setprio(0); } while (0)
#define PG8_WAIT_V(n) asm volatile("s_waitcnt vmcnt(" #n ")" ::: "memory")
#define PG8_WAIT_L(n) asm volatile("s_waitcnt lgkmcnt(" #n ")" ::: "memory")
#define PG8_BAR __builtin_amdgcn_s_barrier()
#define PG8_SCHED __builtin_amdgcn_sched_barrier(0)
    Unit cur, nxt; int ui = 0;
    if (!S.next(0, cur)) return;
    const int unit_scale = 0x7f7f7f7f;
    f32x4 acc[2][2][4][2];
#pragma unroll
    for (int a = 0; a < 2; ++a)
#pragma unroll
        for (int b = 0; b < 2; ++b)
#pragma unroll
            for (int m = 0; m < 4; ++m)
#pragma unroll
                for (int n = 0; n < 2; ++n) acc[a][b][m][n] = (f32x4){0.f, 0.f, 0.f, 0.f};
    bf16x8 At[4][2], B0[2][2], B1[2][2];
    const char* cA = (const char*)g.A + (size_t)cur.pm * tstep; const char* cB = PG8_BTILE(cur.pn);
    S.a_ready(cur);
    if constexpr (SP2) {
        PG8_STAGE(PG8_SB(0, 0), cB, voffB); PG8_STAGE(PG8_SB(0, 1), cB + hstepB, voffB); PG8_STAGE(PG8_SA(0, 0), cA, voffA); PG8_STAGE(PG8_SA(0, 1), cA + hstep, voffA);
        if (wr == 1) PG8_BAR;
        PG8_WAIT_V(2); PG8_BAR;
        PG8_STAGE(PG8_SB(1, 0), cB + kstep, voffB); PG8_STAGE(PG8_SA(1, 0), cA + kstep, voffA); PG8_STAGE(PG8_SB(1, 1), cB + hstepB + kstep, voffB);
        PG8_WAIT_V(6); PG8_BAR;
    } else {
    PG8_STAGE(PG8_SB(0, 0), cB, voffB); PG8_STAGE(PG8_SA(0, 0), cA, voffA); PG8_STAGE(PG8_SB(0, 1), cB + hstepB, voffB); PG8_STAGE(PG8_SA(0, 1), cA + hstep, voffA);
    if (wr == 1) PG8_BAR;
    PG8_WAIT_V(4); PG8_BAR;
    PG8_STAGE(PG8_SB(1, 0), cB + kstep, voffB); PG8_STAGE(PG8_SA(1, 0), cA + kstep, voffA); PG8_STAGE(PG8_SB(1, 1), cB + hstepB + kstep, voffB);
    PG8_WAIT_V(6); PG8_BAR;
    }
    for (;;) {
        const bool has_next = S.next(ui + 1, nxt);
        const char* nA = has_next ? (const char*)g.A + (size_t)nxt.pm * tstep : cA; const char* nB = has_next ? PG8_BTILE(nxt.pn) : cB;
        for (int t = 0; t < nt; t += 2) {
            const bool last = (t == nt - 2);
            const char* a1 = cA + (size_t)(t + 1) * kstep;
            const char* a2 = last ? nA : cA + (size_t)(t + 2) * kstep; const char* b2 = last ? nB : cB + (size_t)(t + 2) * kstep;
            const char* a3 = a2 + kstep; const char* b3 = b2 + kstep;
            if (last && has_next) S.a_ready(nxt);
            if constexpr (SP2) {
            PG8_LDB(B0, 0, 0); PG8_LDB(B1, 0, 1); PG8_SCHED; PG8_LDA(At, 0, 0); PG8_STAGE(PG8_SA(1, 1), a1 + hstep, voffA);
            PG8_WAIT_V(8); PG8_WAIT_L(0); PG8_BAR; PG8_MMA(0, 0, At, B0); PG8_MMA(0, 1, At, B1); PG8_BAR; PG8_SCHED;
            PG8_LDA(At, 0, 1); PG8_STAGE(PG8_SB(0, 0), b2, voffB); PG8_STAGE(PG8_SB(0, 1), b2 + hstepB, voffB); PG8_STAGE(PG8_SA(0, 0), a2, voffA);
            PG8_WAIT_V(8); PG8_WAIT_L(0); PG8_BAR; PG8_MMA(1, 0, At, B0); PG8_MMA(1, 1, At, B1); PG8_BAR; PG8_SCHED;
            PG8_LDB(B0, 1, 0); PG8_LDB(B1, 1, 1); PG8_SCHED; PG8_LDA(At, 1, 0); PG8_STAGE(PG8_SA(0, 1), a2 + hstep, voffA);
            PG8_WAIT_V(8); PG8_WAIT_L(0); PG8_BAR; PG8_MMA(0, 0, At, B0); PG8_MMA(0, 1, At, B1); PG8_BAR; PG8_SCHED;
            PG8_LDA(At, 1, 1); PG8_STAGE(PG8_SB(1, 0), b3, voffB); PG8_STAGE(PG8_SB(1, 1), b3 + hstepB, voffB); PG8_STAGE(PG8_SA(1, 0), a3, voffA);
            PG8_WAIT_V(8); PG8_WAIT_L(0); PG8_BAR; PG8_MMA(1, 0, At, B0); PG8_MMA(1, 1, At, B1); PG8_BAR; PG8_SCHED;
            } else {
            PG8_LDB(B0, 0, 0); PG8_SCHED; PG8_LDA(At, 0, 0); PG8_STAGE(PG8_SA(1, 1), a1 + hstep, voffA);
            PG8_WAIT_L(8); PG8_BAR; PG8_WAIT_L(0); PG8_MMA(0, 0, At, B0); PG8_BAR; PG8_SCHED;
            PG8_LDB(B1, 0, 1); PG8_STAGE(PG8_SB(0, 0), b2, voffB);
            PG8_BAR; PG8_WAIT_L(0); PG8_MMA(0, 1, At, B1); PG8_BAR;
            PG8_LDA(At, 0, 1); PG8_STAGE(PG8_SA(0, 0), a2, voffA);
            PG8_BAR; PG8_WAIT_L(0); PG8_MMA(1, 0, At, B0); PG8_BAR; PG8_SCHED;
            PG8_STAGE(PG8_SB(0, 1), b2 + hstepB, voffB);
            PG8_WAIT_V(6); PG8_BAR; PG8_MMA(1, 1, At, B1); PG8_BAR;
            PG8_LDB(B0, 1, 0); PG8_SCHED; PG8_LDA(At, 1, 0); PG8_STAGE(PG8_SA(0, 1), a2 + hstep, voffA);
            PG8_WAIT_L(8); PG8_BAR; PG8_WAIT_L(0); PG8_MMA(0, 0, At, B0); PG8_BAR; PG8_SCHED;
            PG8_LDB(B1, 1, 1); PG8_STAGE(PG8_SB(1, 0), b3, voffB);
            PG8_BAR; PG8_WAIT_L(0); PG8_MMA(0, 1, At, B1); PG8_BAR;
            PG8_LDA(At, 1, 1); PG8_STAGE(PG8_SA(1, 0), a3, voffA);
            PG8_BAR; PG8_WAIT_L(0); PG8_MMA(1, 0, At, B0); PG8_BAR; PG8_SCHED;
            PG8_STAGE(PG8_SB(1, 1), b3 + hstepB, voffB);
            PG8_WAIT_V(6); PG8_BAR; PG8_MMA(1, 1, At, B1); PG8_BAR;
            }
        }
        if constexpr (ALIGN_EPI) { if (wr == 0) PG8_BAR; }
        E(acc, cur, wr, wc, fr, fq); S.done(cur);
        if (!has_next) break;
#pragma unroll
        for (int a = 0; a < 2; ++a)
#pragma unroll
            for (int b = 0; b < 2; ++b)
#pragma unroll
                for (int m = 0; m < 4; ++m)
#pragma unroll
                    for (int n = 0; n < 2; ++n) acc[a][b][m][n] = (f32x4){0.f, 0.f, 0.f, 0.f};
        cur = nxt; cA = nA; cB = nB; ++ui;
        if constexpr (ALIGN_EPI) { if (wr == 1) PG8_BAR; }
    }
    PG8_WAIT_V(0);
    if constexpr (!ALIGN_EPI) { if (wr == 0) PG8_BAR; }
    PG8_BAR;
#undef PG8_BTILE
#undef PG8_SA
#undef PG8_SB
#undef PG8_STAGE
#undef PG8_LDA
#undef PG8_LDB
#undef PG8_MMA
#undef PG8_WAIT_V
#undef PG8_WAIT_L
#undef PG8_BAR
#undef PG8_SCHED
}

struct EpiBf16 {
    static constexpr bool PERM = true;
    bf16_t* O; const float* cscale; const float* rscale; int ldc, pad; int blk = 0;
    __device__ __forceinline__ void operator()(const f32x4 (&acc)[2][2][4][2], const Unit& u, int wr, int wc, int fr, int fq) const {
        const int row0 = u.pm * BM + wr * 64 + fr, col0 = u.pn * BM + wc * 32 + 8 * fq;
        f32x4 cs[2][2];
#pragma unroll
        for (int bj = 0; bj < 2; ++bj)
#pragma unroll
            for (int n = 0; n < 2; ++n) cs[bj][n] = cscale ? *(const f32x4*)(cscale + col0 + bj * HALF + 4 * n) : (f32x4){1.f, 1.f, 1.f, 1.f};
        float rsv[2][4];
#pragma unroll
        for (int ai = 0; ai < 2; ++ai)
#pragma unroll
            for (int m = 0; m < 4; ++m) rsv[ai][m] = rscale ? rscale[row0 + ai * HALF + m * 16] : 1.0f;
#pragma unroll
        for (int ai = 0; ai < 2; ++ai)
#pragma unroll
            for (int m = 0; m < 4; ++m) { const int r = row0 + ai * HALF + m * 16; bf16_t* rowp = O + (size_t)r * ldc + col0; const float rs = rsv[ai][m];
#pragma unroll
                for (int bj = 0; bj < 2; ++bj) {
                    const f32x4 v0 = acc[ai][bj][m][0] * cs[bj][0] * rs, v1 = acc[ai][bj][m][1] * cs[bj][1] * rs;
                    u32x4 w; w.x = cvt_pk_bf16(v0[0], v0[1]); w.y = cvt_pk_bf16(v0[2], v0[3]); w.z = cvt_pk_bf16(v1[0], v1[1]); w.w = cvt_pk_bf16(v1[2], v1[3]);
                    bf16_t* dst = blk ? O + (size_t)((col0 + bj * HALF) >> 5) * 16384 + (size_t)r * 32 + ((col0 + bj * HALF) & 31) : rowp + bj * HALF;
                    *(u32x4*)dst = w; } }
    }
};
struct EpiF32 {
    static constexpr bool PERM = true;
    _Float16* C; int ldc, pad; const float* cscale = nullptr;
    __device__ __forceinline__ void operator()(const f32x4 (&acc)[2][2][4][2], const Unit& u, int wr, int wc, int fr, int fq) const {
        typedef _Float16 f16x4 __attribute__((ext_vector_type(4)));
        const int row0 = u.pm * BM + wr * 64 + fr;
#pragma unroll
        for (int ai = 0; ai < 2; ++ai)
#pragma unroll
            for (int m = 0; m < 4; ++m) { const int r = row0 + ai * HALF + m * 16; _Float16* gp = C + (size_t)(r >> 2) * 8192 + (r & 3) * 4;
#pragma unroll
                for (int bj = 0; bj < 2; ++bj)
#pragma unroll
                    for (int n = 0; n < 2; ++n) { const int hp = 2 * u.pn + bj, nch = wc * 8 + 2 * fq + n; f32x4 a = acc[ai][bj][m][n];
                        if (cscale) a = a * *(const f32x4*)(cscale + u.pn * BM + bj * HALF + wc * 32 + 8 * fq + 4 * n);
                        const f16x4 hv = {(_Float16)a[0], (_Float16)a[1], (_Float16)a[2], (_Float16)a[3]};
                        *(f16x4*)(gp + (nch * 16 + hp) * 16) = hv; } }
    }
};
template <bool WQ>
struct EpiResT {
    static constexpr bool PERM = true;
    const bf16_t* R; bf16_t* Yb; const float* cscale; int ldc; float alpha; float* part; unsigned char* Yq = nullptr;
    __device__ __forceinline__ void operator()(const f32x4 (&acc)[2][2][4][2], const Unit& u, int wr, int wc, int fr, int fq) const {
        const int row0 = u.pm * BM + wr * 64 + fr, col0 = u.pn * BM + wc * 32 + 8 * fq;
        f32x4 cs[2][2];
#pragma unroll
        for (int bj = 0; bj < 2; ++bj)
#pragma unroll
            for (int n = 0; n < 2; ++n) cs[bj][n] = cscale ? *(const f32x4*)(cscale + col0 + bj * HALF + 4 * n) : (f32x4){1.f, 1.f, 1.f, 1.f};
#pragma unroll
        for (int ai = 0; ai < 2; ++ai) {
            u32x4 rv[4][2];
#pragma unroll
            for (int m = 0; m < 4; ++m)
#pragma unroll
                for (int bj = 0; bj < 2; ++bj) rv[m][bj] = *(const u32x4*)(R + (size_t)(row0 + ai * HALF + m * 16) * ldc + col0 + bj * HALF);
#pragma unroll
            for (int m = 0; m < 4; ++m) { const size_t off = (size_t)(row0 + ai * HALF + m * 16) * ldc + col0; float ps = 0.f, pq = 0.f;
#pragma unroll
                for (int bj = 0; bj < 2; ++bj) { const u32x4 r = rv[m][bj];
                    const f32x4 r0 = {__uint_as_float(r.x << 16), __uint_as_float(r.x & 0xffff0000u), __uint_as_float(r.y << 16), __uint_as_float(r.y & 0xffff0000u)};
                    const f32x4 r1 = {__uint_as_float(r.z << 16), __uint_as_float(r.z & 0xffff0000u), __uint_as_float(r.w << 16), __uint_as_float(r.w & 0xffff0000u)};
                    const f32x4 y0 = r0 * alpha + acc[ai][bj][m][0] * cs[bj][0], y1 = r1 * alpha + acc[ai][bj][m][1] * cs[bj][1];
                    u32x4 w; w.x = cvt_pk_bf16(y0[0], y0[1]); w.y = cvt_pk_bf16(y0[2], y0[3]); w.z = cvt_pk_bf16(y1[0], y1[1]); w.w = cvt_pk_bf16(y1[2], y1[3]);
                    *(u32x4*)(Yb + off + bj * HALF) = w;
                    if (WQ) { uint2 q8; q8.x = pk4_fp8(y0[0], y0[1], y0[2], y0[3]); q8.y = pk4_fp8(y1[0], y1[1], y1[2], y1[3]); *(uint2*)(Yq + off + bj * HALF) = q8; }
                    ps += ((y0[0] + y0[1]) + (y0[2] + y0[3])) + ((y1[0] + y1[1]) + (y1[2] + y1[3]));
                    pq += ((y0[0] * y0[0] + y0[1] * y0[1]) + (y0[2] * y0[2] + y0[3] * y0[3])) + ((y1[0] * y1[0] + y1[1] * y1[1]) + (y1[2] * y1[2] + y1[3] * y1[3])); }
                ps += __shfl_xor(ps, 16); pq += __shfl_xor(pq, 16); ps += __shfl_xor(ps, 32); pq += __shfl_xor(pq, 32);
                if (fq == 0) { float2 o; o.x = ps; o.y = pq; *(float2*)(part + ((size_t)(row0 + ai * HALF + m * 16) * 32 + u.pn * 4 + wc) * 2) = o; } }
            asm volatile("" ::: "memory");
        }
    }
};
}
#define XB_TMO      128
#define XB_XCNT(j)  (256  + 64 * (j))
#define XB_XSUB(j)  (1280 + 64 * (j))
#define XB_XGEN(j)  (2304 + 64 * (j))
#define XB_TOP      3328
#define XB_TOPGEN   3392
#define XCD_BAR_WORDS 3456
#define XB_SPIN_CAP (1u << 22)
#define LAS __attribute__((address_space(3)))

__device__ __forceinline__ unsigned xb_ld(unsigned* p)              { return __hip_atomic_load(p, __ATOMIC_RELAXED, __HIP_MEMORY_SCOPE_AGENT); }
__device__ __forceinline__ unsigned xb_add(unsigned* p, unsigned v) { return __hip_atomic_fetch_add(p, v, __ATOMIC_RELAXED, __HIP_MEMORY_SCOPE_AGENT); }
__device__ __forceinline__ unsigned xb_xcc_id() { return (unsigned)__builtin_amdgcn_s_getreg((3 << 11) | 20) & 0xFu; }
#define XB_SPIN(cond, bar) do { unsigned _sp = 0; while (cond) { __builtin_amdgcn_s_sleep(1); \
    if ((++_sp & 255u) == 0u) { if (xb_ld(&(bar)[XB_TMO])) break; if (_sp > XB_SPIN_CAP) { atomicAdd(&(bar)[XB_TMO], 1u); break; } } } } while (0)

struct XcdBarrier {
    unsigned* bar; unsigned x;
    volatile LAS unsigned* st;
};

__device__ __forceinline__ XcdBarrier xcd_barrier_post(unsigned* bar, volatile LAS unsigned* st) {
    XcdBarrier b; b.bar = bar; b.x = xb_xcc_id(); b.st = st;
    if (threadIdx.x == 0) (void)xb_add(&bar[XB_XCNT(b.x)], 1u);
    return b;
}
__device__ __forceinline__ void xcd_barrier_complete(unsigned* bar, unsigned x, unsigned& nloc, unsigned& nx) {
    const unsigned G = gridDim.x * gridDim.y * gridDim.z;
    unsigned sum, cnt, mine, sp = 0u;
    for (;;) {
        sum = 0u; cnt = 0u; mine = 0u;
#pragma unroll
        for (unsigned j = 0; j < 16; ++j) { const unsigned c = xb_ld(&bar[XB_XCNT(j)]); sum += c; cnt += (c > 0u) ? 1u : 0u; mine = (j == x) ? c : mine; }
        if (sum == G) break;
        __builtin_amdgcn_s_sleep(1);
        if ((++sp & 255u) == 0u) { if (xb_ld(&bar[XB_TMO])) break; if (sp > XB_SPIN_CAP) { atomicAdd(&bar[XB_TMO], 1u); break; } }
    }
    nloc = mine > 0u ? mine : 1u; nx = cnt > 0u ? cnt : 1u;
}

__device__ __forceinline__ void xcd_barrier(const XcdBarrier& b) {
    asm volatile("s_waitcnt vmcnt(0)" ::: "memory");
    __syncthreads();
    if (threadIdx.x == 0) {
        unsigned* bar = b.bar; unsigned bx = b.x; asm volatile("" : "+s"(bar), "+s"(bx));
        __builtin_amdgcn_s_waitcnt(0);
        unsigned nloc = b.st[0], nx = b.st[1];
        if (nloc == 0u) { xcd_barrier_complete(bar, bx, nloc, nx); b.st[0] = nloc; b.st[1] = nx; }
        const unsigned old = xb_add(&bar[XB_XSUB(bx)], 1u);
        const unsigned gen = old / nloc;
        if (old + 1u == (gen + 1u) * nloc) {
            __builtin_amdgcn_fence(__ATOMIC_RELEASE, "agent");
            asm volatile("s_waitcnt vmcnt(0)" ::: "memory");
            const unsigned og = xb_add(&bar[XB_TOP], 1u);
            const unsigned tg = og / nx;
            if (og + 1u == (tg + 1u) * nx) xb_add(&bar[XB_TOPGEN], 1u);
            else XB_SPIN(xb_ld(&bar[XB_TOPGEN]) == tg, bar);
            __builtin_amdgcn_fence(__ATOMIC_ACQUIRE, "agent");
            xb_add(&bar[XB_XGEN(bx)], 1u);
            asm volatile("s_waitcnt vmcnt(0)" ::: "memory");
        } else {
            XB_SPIN(xb_ld(&bar[XB_XGEN(bx)]) == gen, bar);
            __builtin_amdgcn_fence(__ATOMIC_ACQUIRE, "agent");
            asm volatile("s_waitcnt vmcnt(0)" ::: "memory");
        }
    }
    __syncthreads();
}
using pg8::bf16_t;
constexpr int DM = 2048, NB_ = 8, SEQ = 4096, NT = NB_ * SEQ, DEPTH = 4, NMEM = 256, HD = 128;
constexpr int LOCALW = 1536, MEMW = 512, NEXP = 16384;
constexpr float ALPHA = 1.6817928305074290861f;
constexpr float LN_EPS = 1e-5f;
constexpr float QSCALE = 0.08838834764831845f;
constexpr int NTHR = 512, NWAVE = 8;
constexpr int KVLD = 2048 + 128, VTLD = NT + 128;

__device__ __forceinline__ unsigned pk_bf16(float lo, float hi) { unsigned r; asm volatile("v_cvt_pk_bf16_f32 %0, %1, %2" : "=v"(r) : "v"(lo), "v"(hi)); return r; }
__device__ __forceinline__ float bf_lo(unsigned x) { return __uint_as_float(x << 16); }
__device__ __forceinline__ float bf_hi(unsigned x) { return __uint_as_float(x & 0xffff0000u); }
__device__ __forceinline__ float clamp448(float v) { return __builtin_amdgcn_fmed3f(v, -448.0f, 448.0f); }
__device__ __forceinline__ unsigned pk4_e4m3(float a, float b, float c, float d) {
    int r = __builtin_amdgcn_cvt_pk_fp8_f32(clamp448(a), clamp448(b), 0, false); r = __builtin_amdgcn_cvt_pk_fp8_f32(clamp448(c), clamp448(d), r, true); return (unsigned)r; }
__device__ __forceinline__ float wave_sum(float v) {
#pragma unroll
    for (int o = 32; o >= 1; o >>= 1) v += __shfl_xor(v, o);
    return v;
}

__device__ __forceinline__ int otid() { int t = threadIdx.x; asm volatile("" : "+v"(t)); return t; }
__device__ __forceinline__ int obid() { int b = blockIdx.x; asm volatile("" : "+s"(b)); return b; }

struct Params {
    const float *x, *mem, *w_in_a, *w_pool, *s_pool, *w_in_b, *w_mem_kv, *w_o, *ln_g, *ln_b, *peer_wq, *peer_keys, *peer_u, *peer_v;
    float* out; unsigned* bar; float* part; unsigned char* yq; unsigned char* wq_s; float* sc_s;
    bf16_t *wt_in0, *wt_in1, *wt_in2, *wt_in3, *wt_k, *wt_v, *wt_o, *wt_s, *membf, *kmat, *vtm, *xbf, *h, *vtd, *mix;
    bf16_t* xres;
    unsigned char *xq, *mixq, *wq_in0, *wq_in1, *wq_in2, *wq_in3, *wq_o; float *sc_in, *sc_o;
    float *pcs, *pbw, *cs, *bw;
    unsigned char *U8, *V8;
};

__device__ __forceinline__ void cvt_phase(const float* src, bf16_t* dst, size_t n8) {
    const int tid = otid(), bid = obid();
    for (size_t i = (size_t)bid * NTHR + tid; i < n8; i += (size_t)gridDim.x * NTHR) {
        const float4 a = ((const float4*)src)[2 * i], b = ((const float4*)src)[2 * i + 1];
        uint4 o; o.x = pk_bf16(a.x, a.y); o.y = pk_bf16(a.z, a.w); o.z = pk_bf16(b.x, b.y); o.w = pk_bf16(b.z, b.w);
        ((uint4*)dst)[i] = o;
    }
}
__device__ __forceinline__ void cvt8_phase(const float* src, unsigned char* dst, size_t n16) {
    const int tid = otid(), bid = obid();
    for (size_t i = (size_t)bid * NTHR + tid; i < n16; i += (size_t)gridDim.x * NTHR) {
        const float4 a = ((const float4*)src)[4 * i], b = ((const float4*)src)[4 * i + 1], c = ((const float4*)src)[4 * i + 2], d = ((const float4*)src)[4 * i + 3];
        uint4 o; o.x = pk4_e4m3(a.x, a.y, a.z, a.w); o.y = pk4_e4m3(b.x, b.y, b.z, b.w); o.z = pk4_e4m3(c.x, c.y, c.z, c.w); o.w = pk4_e4m3(d.x, d.y, d.z, d.w);
        ((uint4*)dst)[i] = o;
    }
}
__device__ __forceinline__ void cvt_x_phase(const float* src, unsigned char* d8, bf16_t* d16, size_t n4) {
    const int tid = otid(), bid = obid(); const int lane = tid & 63; const size_t wave = (size_t)bid * NWAVE + (tid >> 6), nw = (size_t)gridDim.x * NWAVE;
    for (size_t w0 = wave * 256; w0 < n4; w0 += nw * 256) {
        float4 v[4];
#pragma unroll
        for (int q = 0; q < 4; ++q) v[q] = ((const float4*)src)[w0 + q * 64 + lane];
#pragma unroll
        for (int q = 0; q < 4; ++q) { const size_t i = w0 + q * 64 + lane;
            ((unsigned*)d8)[i] = pk4_e4m3(v[q].x, v[q].y, v[q].z, v[q].w);
            uint2 o; o.x = pk_bf16(v[q].x, v[q].y); o.y = pk_bf16(v[q].z, v[q].w); ((uint2*)d16)[i] = o; }
    }
}
__device__ __forceinline__ void wquant_rows(const bf16_t* src, unsigned char* dst, float* sc, int rows) {
    const int tid = otid(), bid = obid(); const int lane = tid & 63; const int wave = bid * NWAVE + (tid >> 6), nw = gridDim.x * NWAVE;
    for (int row = wave; row < rows; row += nw) {
        uint4 v[4]; float am = 0.f;
#pragma unroll
        for (int c = 0; c < 4; ++c) { v[c] = *(const uint4*)(src + (size_t)row * DM + c * 512 + lane * 8);
            am = fmaxf(am, fmaxf(fmaxf(fmaxf(fabsf(bf_lo(v[c].x)), fabsf(bf_hi(v[c].x))), fmaxf(fabsf(bf_lo(v[c].y)), fabsf(bf_hi(v[c].y)))), fmaxf(fmaxf(fabsf(bf_lo(v[c].z)), fabsf(bf_hi(v[c].z))), fmaxf(fabsf(bf_lo(v[c].w)), fabsf(bf_hi(v[c].w)))))); }
#pragma unroll
        for (int o = 32; o >= 1; o >>= 1) am = fmaxf(am, __shfl_xor(am, o));
        const float s = am > 0.f ? 448.0f / am : 1.0f;
#pragma unroll
        for (int c = 0; c < 4; ++c) { uint2 o; o.x = pk4_e4m3(bf_lo(v[c].x) * s, bf_hi(v[c].x) * s, bf_lo(v[c].y) * s, bf_hi(v[c].y) * s); o.y = pk4_e4m3(bf_lo(v[c].z) * s, bf_hi(v[c].z) * s, bf_lo(v[c].w) * s, bf_hi(v[c].w) * s);
            *(uint2*)(dst + (size_t)row * DM + c * 512 + lane * 8) = o; }
        if (lane == 0) sc[row] = am > 0.f ? am * (1.0f / 448.0f) : 1.0f;
    }
}
__device__ __forceinline__ void transpose_tile(const float* src, int lds_, bf16_t* dst, int ldd, int k0, int n0, LAS float* tile  ) {
    const int tid = otid(); const int tx = tid & 63, ty = tid >> 6;
    for (int r = ty; r < 64; r += NWAVE) tile[r * 65 + tx] = src[(size_t)(k0 + r) * lds_ + n0 + tx];
    __syncthreads();
    for (int r = ty; r < 64; r += NWAVE) dst[(size_t)(n0 + r) * ldd + k0 + tx] = (bf16_t)(pk_bf16(tile[tx * 65 + r], 0.f) & 0xffffu);
    __syncthreads();
}
template <bool B_NMAJOR>
__device__ __forceinline__ void fold_tile(const float* A, int lda, const float* Bm, const float* scale, bf16_t* Out, int NB, int KI, int grp, int n0, int k0, LAS float* sm,
                                          const float* kscale, const float* kbias, float* pcs, float* pbw) {
    LAS float* As = sm;
    LAS float* Bs = sm + 64 * 33;
    const int tid = otid(), tx = tid & 15, ty = tid >> 4;
    float acc[4][4];
#pragma unroll
    for (int a = 0; a < 4; ++a)
#pragma unroll
        for (int b = 0; b < 4; ++b) acc[a][b] = 0.f;
    const float* Bg = Bm + (size_t)grp * NB * KI;
    float ra[4], rb[8];
#define FOLD_FETCH(I0) do { _Pragma("unroll") for (int u = 0; u < 4; ++u) { const int e = tid + u * NTHR, r = e >> 5, c = e & 31; ra[u] = A[(size_t)(k0 + r) * lda + grp * KI + (I0) + c]; } \
        _Pragma("unroll") for (int u = 0; u < 8; ++u) { const int e = tid + u * NTHR; \
            if (!B_NMAJOR) { const int r = e >> 7, c = e & 127; rb[u] = Bg[(size_t)((I0) + r) * NB + n0 + c]; } \
            else { const int c = e >> 5, r = e & 31; rb[u] = Bg[(size_t)(n0 + c) * KI + (I0) + r]; } } } while (0)
#define FOLD_PUT() do { _Pragma("unroll") for (int u = 0; u < 4; ++u) { const int e = tid + u * NTHR, r = e >> 5, c = e & 31; As[r * 33 + c] = ra[u]; } \
        _Pragma("unroll") for (int u = 0; u < 8; ++u) { const int e = tid + u * NTHR; \
            if (!B_NMAJOR) { const int r = e >> 7, c = e & 127; Bs[r * 129 + c] = rb[u]; } else { const int c = e >> 5, r = e & 31; Bs[r * 129 + c] = rb[u]; } } } while (0)
    FOLD_FETCH(0);
    for (int i0 = 0; i0 < KI; i0 += 32) {
        FOLD_PUT();
        __syncthreads();
        if (i0 + 32 < KI) FOLD_FETCH(i0 + 32);
#pragma unroll 8
        for (int i = 0; i < 32; ++i) {
            float a[4], b[4];
#pragma unroll
            for (int q = 0; q < 4; ++q) { a[q] = As[(tx * 4 + q) * 33 + i]; b[q] = Bs[i * 129 + ty * 4 + q]; }
#pragma unroll
            for (int nn = 0; nn < 4; ++nn)
#pragma unroll
                for (int kk = 0; kk < 4; ++kk) acc[nn][kk] += b[nn] * a[kk];
        }
        __syncthreads();
    }
#undef FOLD_FETCH
#undef FOLD_PUT
    float g4[4] = {1.f, 1.f, 1.f, 1.f}, b4[4] = {0.f, 0.f, 0.f, 0.f};
    if (kscale) {
#pragma unroll
        for (int kk = 0; kk < 4; ++kk) { g4[kk] = kscale[k0 + tx * 4 + kk]; b4[kk] = kbias[k0 + tx * 4 + kk]; } }
#pragma unroll
    for (int nn = 0; nn < 4; ++nn) {
        const int n = n0 + ty * 4 + nn; const float s = scale ? scale[grp * NB + n] : 1.0f;
        uint2 o; o.x = pk_bf16(acc[nn][0] * s * g4[0], acc[nn][1] * s * g4[1]); o.y = pk_bf16(acc[nn][2] * s * g4[2], acc[nn][3] * s * g4[3]);
        *(uint2*)(Out + (size_t)(grp * NB + n) * DM + k0 + tx * 4) = o;
        if (kscale) {
            float c = (bf_lo(o.x) + bf_hi(o.x)) + (bf_lo(o.y) + bf_hi(o.y));
            float w = (acc[nn][0] * b4[0] + acc[nn][1] * b4[1]) + (acc[nn][2] * b4[2] + acc[nn][3] * b4[3]);
#pragma unroll
            for (int of = 8; of >= 1; of >>= 1) { c += __shfl_xor(c, of); w += __shfl_xor(w, of); }
            if (tx == 0) { pcs[(size_t)(grp * NB + n) * 32 + (k0 >> 6)] = c; pbw[(size_t)(grp * NB + n) * 32 + (k0 >> 6)] = w * s; }
        }
    }
}

__device__ __forceinline__ void split_bf16x8(const float (&v)[8], pg8::bf16x8& hi, pg8::bf16x8& lo) {
    unsigned h[4], l[4];
#pragma unroll
    for (int j = 0; j < 4; ++j) { h[j] = pk_bf16(v[2 * j], v[2 * j + 1]); l[j] = pk_bf16(v[2 * j] - bf_lo(h[j]), v[2 * j + 1] - bf_hi(h[j])); }
    typedef unsigned u32x4s __attribute__((ext_vector_type(4)));
    hi = __builtin_bit_cast(pg8::bf16x8, (u32x4s){h[0], h[1], h[2], h[3]}); lo = __builtin_bit_cast(pg8::bf16x8, (u32x4s){l[0], l[1], l[2], l[3]});
}
template <bool B_NMAJOR>
__device__ __forceinline__ void fold_tile_mfma(const float* A, int lda, const float* Bm, const float* scale, bf16_t* Out, int NB, int KI, int grp, int n0, int k0,
                                               const float* kscale, const float* kbias, float* pcs, float* pbw) {
    const int tid = otid(), lane = tid & 63, w = tid >> 6, fr = lane & 15, fq = lane >> 4;
    const float* Bg = Bm + (size_t)grp * NB * KI;
    const int n = n0 + w * 16 + fr;
    pg8::f32x4 acc[4];
#pragma unroll
    for (int rt = 0; rt < 4; ++rt) acc[rt] = (pg8::f32x4){0.f, 0.f, 0.f, 0.f};
#pragma unroll 4
    for (int i0 = 0; i0 < KI; i0 += 32) {
        float bv[8];
        if (B_NMAJOR) { const float4 t0 = *(const float4*)(Bg + (size_t)n * KI + i0 + 8 * fq), t1 = *(const float4*)(Bg + (size_t)n * KI + i0 + 8 * fq + 4);
            bv[0] = t0.x; bv[1] = t0.y; bv[2] = t0.z; bv[3] = t0.w; bv[4] = t1.x; bv[5] = t1.y; bv[6] = t1.z; bv[7] = t1.w; }
        else {
#pragma unroll
            for (int j = 0; j < 8; ++j) bv[j] = Bg[(size_t)(i0 + 8 * fq + j) * NB + n]; }
        float av[4][8];
#pragma unroll
        for (int rt = 0; rt < 4; ++rt) { const float* ap = A + (size_t)(k0 + 16 * rt + fr) * lda + grp * KI + i0 + 8 * fq; const float4 t0 = *(const float4*)ap, t1 = *(const float4*)(ap + 4);
            av[rt][0] = t0.x; av[rt][1] = t0.y; av[rt][2] = t0.z; av[rt][3] = t0.w; av[rt][4] = t1.x; av[rt][5] = t1.y; av[rt][6] = t1.z; av[rt][7] = t1.w; }
        pg8::bf16x8 bh, bl; split_bf16x8(bv, bh, bl);
#pragma unroll
        for (int rt = 0; rt < 4; ++rt) { pg8::bf16x8 ah, al; split_bf16x8(av[rt], ah, al);
            acc[rt] = __builtin_amdgcn_mfma_f32_16x16x32_bf16(ah, bh, acc[rt], 0, 0, 0);
            acc[rt] = __builtin_amdgcn_mfma_f32_16x16x32_bf16(ah, bl, acc[rt], 0, 0, 0);
            acc[rt] = __builtin_amdgcn_mfma_f32_16x16x32_bf16(al, bh, acc[rt], 0, 0, 0); }
    }
    const float s = scale ? scale[grp * NB + n] : 1.0f;
    float c = 0.f, wsum = 0.f;
#pragma unroll
    for (int rt = 0; rt < 4; ++rt) {
        float g4[4] = {1.f, 1.f, 1.f, 1.f}, b4[4] = {0.f, 0.f, 0.f, 0.f};
        if (kscale) {
#pragma unroll
            for (int kk = 0; kk < 4; ++kk) { g4[kk] = kscale[k0 + 16 * rt + 4 * fq + kk]; b4[kk] = kbias[k0 + 16 * rt + 4 * fq + kk]; } }
        uint2 o; o.x = pk_bf16(acc[rt][0] * s * g4[0], acc[rt][1] * s * g4[1]); o.y = pk_bf16(acc[rt][2] * s * g4[2], acc[rt][3] * s * g4[3]);
        *(uint2*)(Out + (size_t)(grp * NB + n) * DM + k0 + 16 * rt + 4 * fq) = o;
        c += (bf_lo(o.x) + bf_hi(o.x)) + (bf_lo(o.y) + bf_hi(o.y));
        wsum += (acc[rt][0] * b4[0] + acc[rt][1] * b4[1]) + (acc[rt][2] * b4[2] + acc[rt][3] * b4[3]);
    }
    if (kscale) {
        c += __shfl_xor(c, 16); wsum += __shfl_xor(wsum, 16); c += __shfl_xor(c, 32); wsum += __shfl_xor(wsum, 32);
        if (fq == 0) { pcs[(size_t)(grp * NB + n) * 32 + (k0 >> 6)] = c; pbw[(size_t)(grp * NB + n) * 32 + (k0 >> 6)] = wsum * s; }
    }
}
template <bool B_NMAJOR>
__device__ __forceinline__ void fold_tile_lds(const float* A, int lda, const float* Bm, const float* scale, bf16_t* Out, int NB, int KI, int grp, int n0, int k0, LAS unsigned char* sm,
                                              const float* kscale, const float* kbias, float* pcs, float* pbw) {
    constexpr int FP = 272;
    LAS unsigned char* Ah = sm; LAS unsigned char* Al = sm + 64 * FP; LAS unsigned char* Bh = sm + 128 * FP; LAS unsigned char* Bl = sm + 256 * FP;
    const int tid = otid(), lane = tid & 63, w = tid >> 6, fr = lane & 15, fq = lane >> 4;
    const float* Bg = Bm + (size_t)grp * NB * KI;
    const int n = n0 + w * 16 + fr;
    pg8::f32x4 acc[4];
#pragma unroll
    for (int rt = 0; rt < 4; ++rt) acc[rt] = (pg8::f32x4){0.f, 0.f, 0.f, 0.f};
    typedef unsigned lu2f __attribute__((ext_vector_type(2)));
#pragma unroll 1
    for (int ic = 0; ic < KI; ic += 128) {
        float4 va[4], vb[8];
#pragma unroll
        for (int u = 0; u < 4; ++u) { const int e = tid + u * NTHR, r = e >> 5, c4 = e & 31; va[u] = *(const float4*)(A + (size_t)(k0 + r) * lda + grp * KI + ic + c4 * 4); }
#pragma unroll
        for (int u = 0; u < 8; ++u) { const int e = tid + u * NTHR, r = e >> 5, c4 = e & 31;
            vb[u] = B_NMAJOR ? *(const float4*)(Bg + (size_t)(n0 + r) * KI + ic + c4 * 4) : *(const float4*)(Bg + (size_t)(ic + r) * NB + n0 + c4 * 4); }
        __builtin_amdgcn_sched_barrier(0);
#pragma unroll
        for (int u = 0; u < 4; ++u) { const int e = tid + u * NTHR, r = e >> 5, c4 = e & 31; const float4 v = va[u];
            const unsigned h0 = pk_bf16(v.x, v.y), h1 = pk_bf16(v.z, v.w), l0 = pk_bf16(v.x - bf_lo(h0), v.y - bf_hi(h0)), l1 = pk_bf16(v.z - bf_lo(h1), v.w - bf_hi(h1));
            *(LAS lu2f*)(Ah + r * FP + c4 * 8) = (lu2f){h0, h1}; *(LAS lu2f*)(Al + r * FP + c4 * 8) = (lu2f){l0, l1}; }
#pragma unroll
        for (int u = 0; u < 8; ++u) { const int e = tid + u * NTHR, r = e >> 5, c4 = e & 31; const float4 v = vb[u];
            const unsigned h0 = pk_bf16(v.x, v.y), h1 = pk_bf16(v.z, v.w), l0 = pk_bf16(v.x - bf_lo(h0), v.y - bf_hi(h0)), l1 = pk_bf16(v.z - bf_lo(h1), v.w - bf_hi(h1));
            if (B_NMAJOR) { *(LAS lu2f*)(Bh + r * FP + c4 * 8) = (lu2f){h0, h1}; *(LAS lu2f*)(Bl + r * FP + c4 * 8) = (lu2f){l0, l1}; }
            else {
                *(LAS unsigned short*)(Bh + (c4 * 4 + 0) * FP + r * 2) = (unsigned short)(h0 & 0xffffu); *(LAS unsigned short*)(Bh + (c4 * 4 + 1) * FP + r * 2) = (unsigned short)(h0 >> 16);
                *(LAS unsigned short*)(Bh + (c4 * 4 + 2) * FP + r * 2) = (unsigned short)(h1 & 0xffffu); *(LAS unsigned short*)(Bh + (c4 * 4 + 3) * FP + r * 2) = (unsigned short)(h1 >> 16);
                *(LAS unsigned short*)(Bl + (c4 * 4 + 0) * FP + r * 2) = (unsigned short)(l0 & 0xffffu); *(LAS unsigned short*)(Bl + (c4 * 4 + 1) * FP + r * 2) = (unsigned short)(l0 >> 16);
                *(LAS unsigned short*)(Bl + (c4 * 4 + 2) * FP + r * 2) = (unsigned short)(l1 & 0xffffu); *(LAS unsigned short*)(Bl + (c4 * 4 + 3) * FP + r * 2) = (unsigned short)(l1 >> 16); } }
        __syncthreads();
#pragma unroll
        for (int ks = 0; ks < 4; ++ks) {
            const pg8::bf16x8 bh = *(const LAS pg8::bf16x8*)(Bh + (w * 16 + fr) * FP + (ks * 32 + 8 * fq) * 2), bl = *(const LAS pg8::bf16x8*)(Bl + (w * 16 + fr) * FP + (ks * 32 + 8 * fq) * 2);
#pragma unroll
            for (int rt = 0; rt < 4; ++rt) {
                const pg8::bf16x8 ah = *(const LAS pg8::bf16x8*)(Ah + (rt * 16 + fr) * FP + (ks * 32 + 8 * fq) * 2), al = *(const LAS pg8::bf16x8*)(Al + (rt * 16 + fr) * FP + (ks * 32 + 8 * fq) * 2);
                acc[rt] = __builtin_amdgcn_mfma_f32_16x16x32_bf16(ah, bh, acc[rt], 0, 0, 0);
                acc[rt] = __builtin_amdgcn_mfma_f32_16x16x32_bf16(ah, bl, acc[rt], 0, 0, 0);
                acc[rt] = __builtin_amdgcn_mfma_f32_16x16x32_bf16(al, bh, acc[rt], 0, 0, 0); }
        }
        __syncthreads();
    }
    const float s = scale ? scale[grp * NB + n] : 1.0f;
    float c = 0.f, wsum = 0.f;
#pragma unroll
    for (int rt = 0; rt < 4; ++rt) {
        float g4[4] = {1.f, 1.f, 1.f, 1.f}, b4[4] = {0.f, 0.f, 0.f, 0.f};
        if (kscale) {
#pragma unroll
            for (int kk = 0; kk < 4; ++kk) { g4[kk] = kscale[k0 + 16 * rt + 4 * fq + kk]; b4[kk] = kbias[k0 + 16 * rt + 4 * fq + kk]; } }
        uint2 o; o.x = pk_bf16(acc[rt][0] * s * g4[0], acc[rt][1] * s * g4[1]); o.y = pk_bf16(acc[rt][2] * s * g4[2], acc[rt][3] * s * g4[3]);
        *(uint2*)(Out + (size_t)(grp * NB + n) * DM + k0 + 16 * rt + 4 * fq) = o;
        c += (bf_lo(o.x) + bf_hi(o.x)) + (bf_lo(o.y) + bf_hi(o.y));
        wsum += (acc[rt][0] * b4[0] + acc[rt][1] * b4[1]) + (acc[rt][2] * b4[2] + acc[rt][3] * b4[3]);
    }
    if (kscale) {
        c += __shfl_xor(c, 16); wsum += __shfl_xor(wsum, 16); c += __shfl_xor(c, 32); wsum += __shfl_xor(wsum, 32);
        if (fq == 0) { pcs[(size_t)(grp * NB + n) * 32 + (k0 >> 6)] = c; pbw[(size_t)(grp * NB + n) * 32 + (k0 >> 6)] = wsum * s; }
    }
}
struct FoldT { const float* A; const float* Bg; const float* scale; bf16_t* Out; const float* kscale; const float* kbias; float* pcs; float* pbw; int NB, KI, grp, n0, k0, nmajor; };
__device__ __forceinline__ void fold_desc(const Params& p, int it, FoldT& d) {
    const size_t WSQ = (size_t)DM * DM;
    if (it < 768) { const int ia = it / 384, r = it % 384, grp = r / 96, r2 = r % 96, ntile = r2 / 32, kt = r2 % 32;
        d.A = p.w_in_a + (size_t)ia * WSQ; d.NB = 384; d.KI = 384; d.Bg = p.w_pool + (size_t)ia * 4 * 384 * 384 + (size_t)grp * 384 * 384; d.scale = p.s_pool + (size_t)ia * LOCALW; d.Out = ia == 0 ? p.wt_in0 : p.wt_in2;
        d.grp = grp; d.n0 = ntile * 128; d.k0 = kt * 64; d.nmajor = 0; d.kscale = nullptr; d.kbias = nullptr; d.pcs = nullptr; d.pbw = nullptr; }
    else { const int j = it - 768, l = j / 512, r = j % 512, grp = r / 32, kt = r % 32;
        d.A = p.peer_wq + (size_t)l * WSQ; d.NB = 128; d.KI = 128; d.Bg = p.peer_keys + (size_t)l * 16 * 128 * 128 + (size_t)grp * 128 * 128; d.scale = nullptr; d.Out = p.wt_s + (size_t)l * WSQ;
        d.grp = grp; d.n0 = 0; d.k0 = kt * 64; d.nmajor = 1; d.kscale = p.ln_g + (size_t)(l * 2) * DM; d.kbias = p.ln_b + (size_t)(l * 2) * DM; d.pcs = p.pcs + (size_t)l * DM * 32; d.pbw = p.pbw + (size_t)l * DM * 32; }
}
__device__ __forceinline__ void fold_stream(const Params& p, LAS unsigned char* sm) {
    constexpr int FP = 272;
    LAS unsigned char* Ah = sm; LAS unsigned char* Al = sm + 64 * FP; LAS unsigned char* Bh = sm + 128 * FP; LAS unsigned char* Bl = sm + 256 * FP;
    const int tid = otid(), lane = tid & 63, w = tid >> 6, fr = lane & 15, fq = lane >> 4; const int G = (int)gridDim.x;
    typedef unsigned lu2f __attribute__((ext_vector_type(2)));
    int it = obid(), ic = 0;
    if (it >= 2816) return;
    FoldT d; fold_desc(p, it, d);
    float4 va[4], vb[8];
#define FS_LOAD(D, IC) do { \
        _Pragma("unroll") for (int u = 0; u < 4; ++u) { const int e = tid + u * NTHR, r = e >> 5, c4 = e & 31; va[u] = *(const float4*)((D).A + (size_t)((D).k0 + r) * DM + (D).grp * (D).KI + (IC) + c4 * 4); } \
        _Pragma("unroll") for (int u = 0; u < 8; ++u) { const int e = tid + u * NTHR; \
            const int r = (D).nmajor ? (e >> 5) : (((e >> 6) & 15) * 8 + (e & 7)), c4 = (D).nmajor ? (e & 31) : ((e >> 10) * 8 + ((e >> 3) & 7)); \
            vb[u] = (D).nmajor ? *(const float4*)((D).Bg + (size_t)((D).n0 + r) * (D).KI + (IC) + c4 * 4) : *(const float4*)((D).Bg + (size_t)((IC) + r) * (D).NB + (D).n0 + c4 * 4); } } while (0)
    FS_LOAD(d, 0);
    pg8::f32x4 acc[4];
#pragma unroll
    for (int rt = 0; rt < 4; ++rt) acc[rt] = (pg8::f32x4){0.f, 0.f, 0.f, 0.f};
#pragma unroll 1
    for (;;) {
        int nit = it, nic = ic + 128; if (nic >= d.KI) { nit = it + G; nic = 0; }
        __builtin_amdgcn_sched_barrier(0);
#pragma unroll
        for (int u = 0; u < 4; ++u) { const int e = tid + u * NTHR, r = e >> 5, c4 = e & 31; const float4 v = va[u];
            const unsigned h0 = pk_bf16(v.x, v.y), h1 = pk_bf16(v.z, v.w), l0 = pk_bf16(v.x - bf_lo(h0), v.y - bf_hi(h0)), l1 = pk_bf16(v.z - bf_lo(h1), v.w - bf_hi(h1));
            *(LAS lu2f*)(Ah + r * FP + c4 * 8) = (lu2f){h0, h1}; *(LAS lu2f*)(Al + r * FP + c4 * 8) = (lu2f){l0, l1}; }
#pragma unroll
        for (int u = 0; u < 8; ++u) { const int e = tid + u * NTHR; const float4 v = vb[u];
            const unsigned h0 = pk_bf16(v.x, v.y), h1 = pk_bf16(v.z, v.w), l0 = pk_bf16(v.x - bf_lo(h0), v.y - bf_hi(h0)), l1 = pk_bf16(v.z - bf_lo(h1), v.w - bf_hi(h1));
            if (d.nmajor) { const int r = e >> 5, c4 = e & 31; *(LAS lu2f*)(Bh + r * FP + c4 * 8) = (lu2f){h0, h1}; *(LAS lu2f*)(Bl + r * FP + c4 * 8) = (lu2f){l0, l1}; }
            else {
                const int r = ((e >> 6) & 15) * 8 + (e & 7), c4 = (e >> 10) * 8 + ((e >> 3) & 7);
                const int cb = ((((r >> 3) ^ ((c4 >> 1) & 3))) << 4) + (r & 7) * 2;
                *(LAS unsigned short*)(Bh + (c4 * 4 + 0) * FP + cb) = (unsigned short)(h0 & 0xffffu); *(LAS unsigned short*)(Bh + (c4 * 4 + 1) * FP + cb) = (unsigned short)(h0 >> 16);
                *(LAS unsigned short*)(Bh + (c4 * 4 + 2) * FP + cb) = (unsigned short)(h1 & 0xffffu); *(LAS unsigned short*)(Bh + (c4 * 4 + 3) * FP + cb) = (unsigned short)(h1 >> 16);
                *(LAS unsigned short*)(Bl + (c4 * 4 + 0) * FP + cb) = (unsigned short)(l0 & 0xffffu); *(LAS unsigned short*)(Bl + (c4 * 4 + 1) * FP + cb) = (unsigned short)(l0 >> 16);
                *(LAS unsigned short*)(Bl + (c4 * 4 + 2) * FP + cb) = (unsigned short)(l1 & 0xffffu); *(LAS unsigned short*)(Bl + (c4 * 4 + 3) * FP + cb) = (unsigned short)(l1 >> 16); } }
        __syncthreads();
        FoldT dn = d; const bool more = nit < 2816;
        if (more) { if (nic == 0) fold_desc(p, nit, dn); FS_LOAD(dn, nic); }
        __builtin_amdgcn_sched_barrier(0);
#pragma unroll
        for (int ks = 0; ks < 4; ++ks) {
            const int bo_ = (w * 16 + fr) * FP + (((ks * 4 + fq) ^ (d.nmajor ? 0 : (((w * 16 + fr) >> 3) & 3))) << 4);
            const pg8::bf16x8 bh = *(const LAS pg8::bf16x8*)(Bh + bo_), bl = *(const LAS pg8::bf16x8*)(Bl + bo_);
#pragma unroll
            for (int rt = 0; rt < 4; ++rt) {
                const pg8::bf16x8 ah = *(const LAS pg8::bf16x8*)(Ah + (rt * 16 + fr) * FP + (ks * 32 + 8 * fq) * 2), al = *(const LAS pg8::bf16x8*)(Al + (rt * 16 + fr) * FP + (ks * 32 + 8 * fq) * 2);
                acc[rt] = __builtin_amdgcn_mfma_f32_16x16x32_bf16(ah, bh, acc[rt], 0, 0, 0);
                acc[rt] = __builtin_amdgcn_mfma_f32_16x16x32_bf16(ah, bl, acc[rt], 0, 0, 0);
                acc[rt] = __builtin_amdgcn_mfma_f32_16x16x32_bf16(al, bh, acc[rt], 0, 0, 0); }
        }
        __syncthreads();
        if (nic == 0) {
            const int n = d.n0 + w * 16 + fr;
            const float s = d.scale ? d.scale[d.grp * d.NB + n] : 1.0f;
            float c = 0.f, wsum = 0.f;
#pragma unroll
            for (int rt = 0; rt < 4; ++rt) {
                float g4[4] = {1.f, 1.f, 1.f, 1.f}, b4[4] = {0.f, 0.f, 0.f, 0.f};
                if (d.kscale) {
#pragma unroll
                    for (int kk = 0; kk < 4; ++kk) { g4[kk] = d.kscale[d.k0 + 16 * rt + 4 * fq + kk]; b4[kk] = d.kbias[d.k0 + 16 * rt + 4 * fq + kk]; } }
                uint2 o; o.x = pk_bf16(acc[rt][0] * s * g4[0], acc[rt][1] * s * g4[1]); o.y = pk_bf16(acc[rt][2] * s * g4[2], acc[rt][3] * s * g4[3]);
                *(uint2*)(d.Out + (size_t)(d.grp * d.NB + n) * DM + d.k0 + 16 * rt + 4 * fq) = o;
                c += (bf_lo(o.x) + bf_hi(o.x)) + (bf_lo(o.y) + bf_hi(o.y));
                wsum += (acc[rt][0] * b4[0] + acc[rt][1] * b4[1]) + (acc[rt][2] * b4[2] + acc[rt][3] * b4[3]);
                acc[rt] = (pg8::f32x4){0.f, 0.f, 0.f, 0.f};
            }
            if (d.kscale) {
                c += __shfl_xor(c, 16); wsum += __shfl_xor(wsum, 16); c += __shfl_xor(c, 32); wsum += __shfl_xor(wsum, 32);
                if (fq == 0) { d.pcs[(size_t)(d.grp * d.NB + n) * 32 + (d.k0 >> 6)] = c; d.pbw[(size_t)(d.grp * d.NB + n) * 32 + (d.k0 >> 6)] = wsum * s; }
            }
        }
        if (!more) break;
        d = dn; it = nit; ic = nic;
    }
#undef FS_LOAD
}
typedef float f32x2 __attribute__((ext_vector_type(2)));
typedef int i32x8p __attribute__((ext_vector_type(8)));
typedef float f32x4p __attribute__((ext_vector_type(4)));
constexpr int ROWB = 1152;
__device__ __forceinline__ float clamp6(float v) { return __builtin_amdgcn_fmed3f(v, -6.0f, 6.0f); }
template <bool GROUPED>
__device__ __forceinline__ void quant_row(const float4 (&v)[8], unsigned char* dst, int row, int lane) {
    float amax = 0.f;
#pragma unroll
    for (int c = 0; c < 8; ++c) amax = fmaxf(amax, fmaxf(fmaxf(fabsf(v[c].x), fabsf(v[c].y)), fmaxf(fabsf(v[c].z), fabsf(v[c].w))));
    unsigned sb;
    if (GROUPED) {
        float g = fmaxf(amax, __shfl_xor(amax, 16)); g = fmaxf(g, __shfl_xor(g, 32));
        sb = pk_bf16(g * (1.0f / 6.0f), 0.f) & 0xffffu;
        float sc = __uint_as_float(sb << 16);
        for (int it = 0; it < 24 && amax <= 3.5f * sc; ++it) { sc *= 0.5f; }
        sb = __float_as_uint(sc) >> 16;
    } else sb = pk_bf16(amax * (1.0f / 6.0f), 0.f) & 0xffffu;
    const float s2 = __uint_as_float(sb << 16);
    const float inv = s2 > 0.f ? 1.0f / s2 : 0.f;
    unsigned q[4];
#pragma unroll
    for (int d = 0; d < 4; ++d) { unsigned r = 0u;
        r = __builtin_amdgcn_cvt_scalef32_pk_fp4_f32(r, clamp6(v[2 * d].x * inv), clamp6(v[2 * d].y * inv), 1.0f, 0);
        r = __builtin_amdgcn_cvt_scalef32_pk_fp4_f32(r, clamp6(v[2 * d].z * inv), clamp6(v[2 * d].w * inv), 1.0f, 1);
        r = __builtin_amdgcn_cvt_scalef32_pk_fp4_f32(r, clamp6(v[2 * d + 1].x * inv), clamp6(v[2 * d + 1].y * inv), 1.0f, 2);
        r = __builtin_amdgcn_cvt_scalef32_pk_fp4_f32(r, clamp6(v[2 * d + 1].z * inv), clamp6(v[2 * d + 1].w * inv), 1.0f, 3);
        q[d] = r; }
    uint4 o; o.x = q[0]; o.y = q[1]; o.z = q[2]; o.w = q[3];
    *(uint4*)(dst + (size_t)row * ROWB + lane * 16) = o;
    *(unsigned short*)(dst + (size_t)row * ROWB + 1024 + lane * 2) = (unsigned short)sb;
}
template <bool GROUPED>
__device__ __forceinline__ void quant_phase(const float* src, unsigned char* dst, int nrows) {
    const int tid = otid(), bid = obid(); const int lane = tid & 63; const int wave = bid * NWAVE + (tid >> 6), nw = gridDim.x * NWAVE;
    for (int row = wave; row < nrows; row += 3 * nw) {
        float4 va[8], vb[8], vc[8];
        const int r1 = row + nw, r2 = row + 2 * nw;
#pragma unroll
        for (int c = 0; c < 8; ++c) va[c] = *(const float4*)(src + (size_t)row * DM + c * 256 + lane * 4);
        if (r1 < nrows) {
#pragma unroll
            for (int c = 0; c < 8; ++c) vb[c] = *(const float4*)(src + (size_t)r1 * DM + c * 256 + lane * 4); }
        if (r2 < nrows) {
#pragma unroll
            for (int c = 0; c < 8; ++c) vc[c] = *(const float4*)(src + (size_t)r2 * DM + c * 256 + lane * 4); }
        __builtin_amdgcn_sched_barrier(0);
        quant_row<GROUPED>(va, dst, row, lane);
        if (r1 < nrows) quant_row<GROUPED>(vb, dst, r1, lane);
        if (r2 < nrows) quant_row<GROUPED>(vc, dst, r2, lane);
    }
}

__device__ __forceinline__ void transpose_wave(const float* src, int lds_, bf16_t* dst, int ldd, int k0, int n0, LAS float* tile, int lane) {
    float4 v[8];
#pragma unroll
    for (int it = 0; it < 8; ++it) v[it] = *(const float4*)(src + (size_t)(k0 + it * 8 + (lane >> 3)) * lds_ + n0 + (lane & 7) * 4);
#pragma unroll
    for (int it = 0; it < 8; ++it) { LAS float* t = tile + (it * 8 + (lane >> 3)) * 33 + (lane & 7) * 4; t[0] = v[it].x; t[1] = v[it].y; t[2] = v[it].z; t[3] = v[it].w; }
    __builtin_amdgcn_fence(__ATOMIC_RELEASE, "wavefront"); __builtin_amdgcn_wave_barrier(); __builtin_amdgcn_fence(__ATOMIC_ACQUIRE, "wavefront");
#pragma unroll
    for (int it = 0; it < 4; ++it) { const int n = it * 8 + (lane >> 3), kc = (lane & 7) * 8; float f[8];
#pragma unroll
        for (int j = 0; j < 8; ++j) f[j] = tile[(kc + j) * 33 + n];
        uint4 o; o.x = pk_bf16(f[0], f[1]); o.y = pk_bf16(f[2], f[3]); o.z = pk_bf16(f[4], f[5]); o.w = pk_bf16(f[6], f[7]);
        *(uint4*)(dst + (size_t)(n0 + n) * ldd + k0 + kc) = o; }
    __builtin_amdgcn_fence(__ATOMIC_RELEASE, "wavefront"); __builtin_amdgcn_wave_barrier(); __builtin_amdgcn_fence(__ATOMIC_ACQUIRE, "wavefront");
}
__device__ __forceinline__ void cvt_x_half(const float* src, unsigned char* d8, bf16_t* d16, size_t n4, int wv, int lane, int bid) {
    const size_t wave = (size_t)bid * 4 + wv, nw = (size_t)gridDim.x * 4;
    for (size_t w0 = wave * 512; w0 < n4; w0 += nw * 512) {
        float4 v[8];
#pragma unroll
        for (int q = 0; q < 8; ++q) v[q] = ((const float4*)src)[w0 + q * 64 + lane];
#pragma unroll
        for (int q = 0; q < 8; ++q) { const size_t i = w0 + q * 64 + lane;
            ((unsigned*)d8)[i] = pk4_e4m3(v[q].x, v[q].y, v[q].z, v[q].w);
            uint2 o; o.x = pk_bf16(v[q].x, v[q].y); o.y = pk_bf16(v[q].z, v[q].w); ((uint2*)d16)[i] = o; }
    }
}
__device__ __forceinline__ void cvt_half(const float* src, bf16_t* dst, size_t n8, int t256, int bid) {
    for (size_t i = (size_t)bid * 256 + t256; i < n8; i += (size_t)gridDim.x * 256) {
        const float4 a = ((const float4*)src)[2 * i], b = ((const float4*)src)[2 * i + 1];
        uint4 o; o.x = pk_bf16(a.x, a.y); o.y = pk_bf16(a.z, a.w); o.z = pk_bf16(b.x, b.y); o.w = pk_bf16(b.z, b.w);
        ((uint4*)dst)[i] = o;
    }
}
__device__ __forceinline__ void prologue_phase(const Params& p, LAS unsigned char* lds) {
    const size_t WSQ = (size_t)DM * DM;
    LAS float* sm = (LAS float*)lds;
    const int bid = obid();
    {
        const int tidw = otid(); const int lanew = tidw & 63, wvw = tidw >> 6;
        LAS float* wt = sm + wvw * (64 * 33);
        if (wvw < 4) { cvt_x_half(p.x, p.xq, p.xres, (size_t)NT * DM / 4, wvw, lanew, bid); cvt_half(p.mem, p.membf, (size_t)NB_ * NMEM * DM / 8, tidw, bid); }
        else
        for (int it = bid * 4 + (wvw - 4); it < 23552; it += gridDim.x * 4) {
            if (it < 10240) { const int ib = it / 5120, r = it % 5120, nt = r % 160, kt = r / 160;
                const int n0 = nt * 32, drow = n0 < 3072 ? n0 : (n0 < 4608 ? n0 + 512 : n0 - 1536);
                transpose_wave(p.w_in_b + (size_t)ib * DM * 5120 + n0, 5120, (ib == 0 ? p.wt_in1 : p.wt_in3) + (size_t)drow * DM, DM, kt * 64, 0, wt, lanew); }
            else if (it < 11264) { const int j = it - 10240, ia = j / 512, r = j % 512, nt = r % 16, kt = r / 16;
                transpose_wave(p.w_in_a + (size_t)ia * WSQ + LOCALW, DM, (ia == 0 ? p.wt_in0 : p.wt_in2) + (size_t)LOCALW * DM, DM, kt * 64, nt * 32, wt, lanew); }
            else if (it < 15360) { const int j = it - 11264, l = j / 1024, r = j % 1024, nt = r % 32, kt = r / 32;
                const int n0 = nt * 32; bf16_t* dst = (n0 < 512 ? p.wt_k : p.wt_v) + (size_t)(l * 512 + (n0 & 511)) * DM;
                transpose_wave(p.w_mem_kv + (size_t)l * DM * 1024 + n0, 1024, dst, DM, kt * 64, 0, wt, lanew); }
            else { const int j = it - 15360, l = j / 2048, r = j % 2048, nt = r % 64, kt = r / 64;
                transpose_wave(p.w_o + (size_t)l * WSQ, DM, p.wt_o + (size_t)l * WSQ, DM, kt * 64, nt * 32, wt, lanew); }
        }
        __syncthreads();
    }
    fold_stream(p, lds);
}

__device__ __forceinline__ void pool_add(float (&s)[8], const uint4 v, float sg) {
    s[0] += sg * bf_lo(v.x); s[1] += sg * bf_hi(v.x); s[2] += sg * bf_lo(v.y); s[3] += sg * bf_hi(v.y); s[4] += sg * bf_lo(v.z); s[5] += sg * bf_hi(v.z); s[6] += sg * bf_lo(v.w); s[7] += sg * bf_hi(v.w);
}
__device__ __forceinline__ void pool_phase(const bf16_t* h, unsigned char* mixq) {
    const int tid = otid(), bid = obid();
    for (int item = bid * NTHR + tid; item < NB_ * 64 * 192; item += gridDim.x * NTHR) {
        const int c = (item % 192) * 8, run = (item / 192) & 63, b = item / (192 * 64);
        const int w = 2 << (c / 384), t0 = run * 64;
        const bf16_t* base = h + (size_t)b * SEQ * DM + c;
        float s[8];
#pragma unroll
        for (int j = 0; j < 8; ++j) s[j] = 0.f;
        {
            uint4 wv[16];
#pragma unroll
            for (int i = 1; i <= 16; ++i) { const int t = t0 - i; wv[i - 1] = (i <= w && t >= 0) ? *(const uint4*)(base + (size_t)t * DM) : make_uint4(0u, 0u, 0u, 0u); }
#pragma unroll
            for (int i = 0; i < 16; ++i) pool_add(s, wv[i], 1.0f);
        }
#pragma unroll 1
        for (int tb = 0; tb < 64; tb += 8) {
            uint4 cu[8], ol[8];
#pragma unroll
            for (int j = 0; j < 8; ++j) { const int t = t0 + tb + j; cu[j] = *(const uint4*)(base + (size_t)t * DM);
                ol[j] = (t - w >= 0) ? *(const uint4*)(base + (size_t)(t - w) * DM) : make_uint4(0u, 0u, 0u, 0u); }
#pragma unroll
            for (int j = 0; j < 8; ++j) { const int t = t0 + tb + j;
                pool_add(s, cu[j], 1.0f); pool_add(s, ol[j], -1.0f);
                const float inv = 1.0f / (float)((t + 1) < w ? (t + 1) : w);
                uint2 o;
                o.x = pk4_e4m3(s[0] * inv - bf_lo(cu[j].x), s[1] * inv - bf_hi(cu[j].x), s[2] * inv - bf_lo(cu[j].y), s[3] * inv - bf_hi(cu[j].y));
                o.y = pk4_e4m3(s[4] * inv - bf_lo(cu[j].z), s[5] * inv - bf_hi(cu[j].z), s[6] * inv - bf_lo(cu[j].w), s[7] * inv - bf_hi(cu[j].w));
                *(uint2*)(mixq + ((size_t)b * SEQ + t) * DM + c) = o; }
        }
    }
}

typedef float f32x16 __attribute__((ext_vector_type(16)));
using pg8::bf16x8;
constexpr float SCL2 = QSCALE * 1.4426950408889634f;

typedef unsigned rawv __attribute__((ext_vector_type(4)));
constexpr int KPITCH = 272, VPITCH = 80, WBUF = 10240;
__device__ __forceinline__ void tile_ld_rows(rawv (&raw)[8], const bf16_t* p, size_t ps, int lane) {
    const char* base = (const char*)p; const unsigned off = (unsigned)((size_t)(lane >> 4) * ps + (lane & 15) * 8) * 2u;
#pragma unroll
    for (int i = 0; i < 8; ++i) raw[i] = *(const rawv*)(base + (size_t)(4 * i) * ps * 2 + off);
}
__device__ __forceinline__ void tile_st_rows(const rawv (&raw)[8], LAS unsigned char* wb, int lane) {
#pragma unroll
    for (int i = 0; i < 8; ++i) *(LAS rawv*)(wb + (4 * i + (lane >> 4)) * KPITCH + (lane & 15) * 16) = raw[i];
}
__device__ __forceinline__ void tile_ld_vt(rawv (&raw)[8], const bf16_t* p, size_t ps, int lane) {
    const char* base = (const char*)p; const unsigned off = (unsigned)((size_t)(lane >> 2) * ps + (lane & 3) * 8) * 2u;
#pragma unroll
    for (int i = 0; i < 8; ++i) raw[i] = *(const rawv*)(base + (size_t)(16 * i) * ps * 2 + off);
}
__device__ __forceinline__ void tile_st_vt(const rawv (&raw)[8], LAS unsigned char* wb, int lane) {
#pragma unroll
    for (int i = 0; i < 8; ++i) *(LAS rawv*)(wb + (16 * i + (lane >> 2)) * VPITCH + (lane & 3) * 16) = raw[i];
}
#define ATT_WSYNC() do { __builtin_amdgcn_fence(__ATOMIC_RELEASE, "wavefront"); __builtin_amdgcn_wave_barrier(); __builtin_amdgcn_fence(__ATOMIC_ACQUIRE, "wavefront"); } while (0)

template <int NTL, bool FIRST>
__device__ __forceinline__ void attn_chunk(const bf16x8 (&qf)[8], const bf16_t* kptr, size_t ks, const bf16_t* vtptr, size_t vs,
                                           int t_lo, bool mask0, bool maskL, float& m, float& l, f32x16 (&o)[4], int lane, LAS unsigned char* wb) {
    const int c = lane & 31, hf = lane >> 5;
    const int krow = (c & 0x13) | ((c & 4) << 1) | ((c & 8) >> 1);
    constexpr int RN = (FIRST && NTL <= 4) ? 2 : 1;
    f32x16 S[NTL];
    {
        rawv raw[RN][8];
#define ATT_KT(T) (kptr + (size_t)((((T) >= t_lo ? (T) : t_lo)) * 32) * ks)
#pragma unroll
        for (int t = 0; t < RN; ++t) if (t < NTL) tile_ld_rows(raw[t], ATT_KT(t), ks, lane);
        __builtin_amdgcn_sched_barrier(0);
#pragma unroll
        for (int t = 0; t < NTL; ++t) {
            tile_st_rows(raw[t % RN], wb, lane);
            ATT_WSYNC();
            __builtin_amdgcn_sched_barrier(0);
            if (t + RN < NTL) tile_ld_rows(raw[t % RN], ATT_KT(t + RN), ks, lane);
            __builtin_amdgcn_sched_barrier(0);
#pragma unroll
            for (int v = 0; v < 16; ++v) S[t][v] = 0.f;
#pragma unroll
            for (int s4 = 0; s4 < 8; s4 += 4) {
                bf16x8 kf[4];
#pragma unroll
                for (int s = 0; s < 4; ++s) kf[s] = *(const LAS bf16x8*)(wb + krow * KPITCH + (s4 + s) * 32 + hf * 16);
#pragma unroll
                for (int s = 0; s < 4; ++s) S[t] = __builtin_amdgcn_mfma_f32_32x32x16_bf16(kf[s], qf[s4 + s], S[t], 0, 0, 0);
                __builtin_amdgcn_sched_barrier(0);
            }
            ATT_WSYNC();
            __builtin_amdgcn_sched_barrier(0);
        }
#undef ATT_KT
    }
    float mx = -__builtin_inff();
#pragma unroll
    for (int t = 0; t < NTL; ++t) {
        const bool on = t >= t_lo;
#pragma unroll
        for (int v = 0; v < 16; ++v) {
            const int a = 16 * (v >> 3) + 8 * hf + (v & 7);
            float s = S[t][v] * SCL2;
            bool keep = on;
            if (t == 0) keep = keep && !(mask0 && a < c);
            if (t == NTL - 1) keep = keep && !(maskL && a > c);
            s = keep ? s : -__builtin_inff();
            S[t][v] = s; mx = fmaxf(mx, s);
        }
    }
    mx = fmaxf(mx, __shfl_xor(mx, 32));
    const float mn = FIRST ? mx : fmaxf(m, mx);
    if (FIRST) {
        l = 0.f;
#pragma unroll
        for (int dt = 0; dt < 4; ++dt)
#pragma unroll
            for (int v = 0; v < 16; ++v) o[dt][v] = 0.f;
    } else {
        const float corr = __builtin_amdgcn_exp2f(m - mn);
        l *= corr;
#pragma unroll
        for (int dt = 0; dt < 4; ++dt)
#pragma unroll
            for (int v = 0; v < 16; ++v) o[dt][v] *= corr;
    }
    m = mn;
    typedef unsigned u32x4v __attribute__((ext_vector_type(4)));
    u32x4v P[NTL][2]; float ps = 0.f;
#pragma unroll
    for (int t = 0; t < NTL; ++t) {
        float p[16];
#pragma unroll
        for (int v = 0; v < 16; ++v) { p[v] = __builtin_amdgcn_exp2f(S[t][v] - mn); ps += p[v]; }
#pragma unroll
        for (int s = 0; s < 2; ++s) { P[t][s].x = pk_bf16(p[8 * s + 0], p[8 * s + 1]); P[t][s].y = pk_bf16(p[8 * s + 2], p[8 * s + 3]); P[t][s].z = pk_bf16(p[8 * s + 4], p[8 * s + 5]); P[t][s].w = pk_bf16(p[8 * s + 6], p[8 * s + 7]); }
    }
    l += ps;
    {
        constexpr int VN = NTL <= 4 ? 2 : 1;
        rawv raw[VN][8];
#define ATT_VT(T) (vtptr + (size_t)(((T) >= t_lo ? (T) : t_lo)) * 16384)
#pragma unroll
        for (int t = 0; t < VN; ++t) if (t < NTL) tile_ld_vt(raw[t], ATT_VT(t), vs, lane);
        __builtin_amdgcn_sched_barrier(0);
#pragma unroll
        for (int t = 0; t < NTL; ++t) {
            tile_st_vt(raw[t % VN], wb, lane);
            ATT_WSYNC();
            __builtin_amdgcn_sched_barrier(0);
            if (t + VN < NTL) tile_ld_vt(raw[t % VN], ATT_VT(t + VN), vs, lane);
            __builtin_amdgcn_sched_barrier(0);
#pragma unroll
            for (int s = 0; s < 2; ++s) { const bf16x8 pf = __builtin_bit_cast(bf16x8, P[t][s]);
                bf16x8 vf[4];
#pragma unroll
                for (int dt = 0; dt < 4; ++dt) vf[dt] = *(const LAS bf16x8*)(wb + (dt * 32 + c) * VPITCH + s * 32 + hf * 16);
#pragma unroll
                for (int dt = 0; dt < 4; ++dt) o[dt] = __builtin_amdgcn_mfma_f32_32x32x16_bf16(vf[dt], pf, o[dt], 0, 0, 0); }
            ATT_WSYNC();
            __builtin_amdgcn_sched_barrier(0);
        }
#undef ATT_VT
    }
}
__device__ __forceinline__ void attn_load_q(bf16x8 (&qf)[8], const bf16_t* q, size_t qs, int lane, LAS unsigned char* wb) {
    rawv raw[8]; tile_ld_rows(raw, q, qs, lane);
    tile_st_rows(raw, wb, lane);
    ATT_WSYNC();
#pragma unroll
    for (int s = 0; s < 8; ++s) qf[s] = *(const LAS bf16x8*)(wb + (lane & 31) * KPITCH + s * 32 + (lane >> 5) * 16);
    ATT_WSYNC();
}
__device__ __forceinline__ float attn_store(const f32x16 (&o)[4], float m, float l, bf16_t* outp, size_t os, int lane, LAS unsigned char* wb) {
    const int c = lane & 31, hf = lane >> 5;
    const float lt = l + __shfl_xor(l, 32), inv = 1.0f / lt;
    typedef unsigned lu2s __attribute__((ext_vector_type(2)));
#pragma unroll
    for (int dt = 0; dt < 4; ++dt)
#pragma unroll
        for (int i = 0; i < 4; ++i) {
            lu2s w; w[0] = pk_bf16(o[dt][4 * i + 0] * inv, o[dt][4 * i + 1] * inv); w[1] = pk_bf16(o[dt][4 * i + 2] * inv, o[dt][4 * i + 3] * inv);
            *(LAS lu2s*)(wb + c * KPITCH + (dt * 32 + 8 * i + 4 * hf) * 2) = w;
        }
    ATT_WSYNC();
#pragma unroll
    for (int i = 0; i < 8; ++i) { const int r = 4 * i + (lane >> 4); const rawv v = *(const LAS rawv*)(wb + r * KPITCH + (lane & 15) * 16);
        *(rawv*)((char*)outp + (size_t)r * os * 2 + (lane & 15) * 16) = v; }
    ATT_WSYNC();
    return m + __builtin_amdgcn_logf(lt);
}

__device__ __forceinline__ float attn_store8(const f32x16 (&o)[4], float m, float l, unsigned char* outp, size_t os, int lane, LAS unsigned char* wb) {
    const int c = lane & 31, hf = lane >> 5;
    const float lt = l + __shfl_xor(l, 32), inv = 1.0f / lt;
#pragma unroll
    for (int dt = 0; dt < 4; ++dt)
#pragma unroll
        for (int i = 0; i < 4; ++i)
            *(LAS unsigned*)(wb + c * 144 + dt * 32 + 8 * i + 4 * hf) = pk4_e4m3(o[dt][4 * i + 0] * inv, o[dt][4 * i + 1] * inv, o[dt][4 * i + 2] * inv, o[dt][4 * i + 3] * inv);
    ATT_WSYNC();
#pragma unroll
    for (int u = 0; u < 4; ++u) { const int r = u * 8 + (lane >> 3); const rawv v = *(const LAS rawv*)(wb + r * 144 + (lane & 7) * 16);
        *(rawv*)(outp + (size_t)r * os + (lane & 7) * 16) = v; }
    ATT_WSYNC();
    return m + __builtin_amdgcn_logf(lt);
}
__device__ __forceinline__ void attn_store_q(const f32x16 (&o)[4], float l, unsigned char* outp, size_t os, int lane, LAS unsigned char* ws) {
    const int c = lane & 31, hf = lane >> 5;
    const float lt = l + __shfl_xor(l, 32), inv = 1.0f / lt;
#pragma unroll
    for (int ps = 0; ps < 2; ++ps) {
        if ((c >> 4) == ps) {
#pragma unroll
            for (int dt = 0; dt < 4; ++dt)
#pragma unroll
                for (int i = 0; i < 4; ++i)
                    *(LAS unsigned*)(ws + (c & 15) * 144 + dt * 32 + 8 * i + 4 * hf) = pk4_e4m3(o[dt][4 * i + 0] * inv, o[dt][4 * i + 1] * inv, o[dt][4 * i + 2] * inv, o[dt][4 * i + 3] * inv);
        }
        ATT_WSYNC();
#pragma unroll
        for (int u = 0; u < 2; ++u) { const int r = u * 8 + (lane >> 3); const rawv v = *(const LAS rawv*)(ws + r * 144 + (lane & 7) * 16);
            *(rawv*)(outp + (size_t)(ps * 16 + r) * os + (lane & 7) * 16) = v; }
        ATT_WSYNC();
    }
}
constexpr int MVPITCH = 528, MEMK_OFF = 6144, MEMV_OFF = MEMK_OFF + 256 * KPITCH, MEM_LDS_END = MEMV_OFF + 128 * MVPITCH;
__device__ __forceinline__ void memattn_fill(const bf16_t* kmat, const bf16_t* vtm, int layer, int b, int hh, LAS unsigned char* lds, int tid) {
    const bf16_t* kp = kmat + (size_t)(b * NMEM) * KVLD + layer * 512 + hh * HD;
    const bf16_t* vp = vtm + (size_t)(layer * 512 + hh * HD) * KVLD + b * NMEM;
    rawv rk[8], rv[8];
#pragma unroll
    for (int i = 0; i < 8; ++i) { const int pc = tid + i * NTHR; rk[i] = *(const rawv*)(kp + (size_t)(pc >> 4) * KVLD + (pc & 15) * 8); }
#pragma unroll
    for (int i = 0; i < 8; ++i) { const int pc = tid + i * NTHR; rv[i] = *(const rawv*)(vp + (size_t)(pc >> 5) * KVLD + (pc & 31) * 8); }
#pragma unroll
    for (int i = 0; i < 8; ++i) { const int pc = tid + i * NTHR; *(LAS rawv*)(lds + MEMK_OFF + (pc >> 4) * KPITCH + (pc & 15) * 16) = rk[i]; }
#pragma unroll
    for (int i = 0; i < 8; ++i) { const int pc = tid + i * NTHR; *(LAS rawv*)(lds + MEMV_OFF + (pc >> 5) * MVPITCH + (pc & 31) * 16) = rv[i]; }
}
template <bool FIRST>
__device__ __forceinline__ void memattn_chunk(const bf16x8 (&qf)[8], int T0, float& m, float& l, f32x16 (&o)[4], int lane, LAS unsigned char* lds) {
    const int c = lane & 31, hf = lane >> 5;
    const int krow = (c & 0x13) | ((c & 4) << 1) | ((c & 8) >> 1);
    f32x16 S[4];
#pragma unroll
    for (int t = 0; t < 4; ++t) {
#pragma unroll
        for (int v = 0; v < 16; ++v) S[t][v] = 0.f;
#pragma unroll
        for (int s4 = 0; s4 < 8; s4 += 4) {
            bf16x8 kf[4];
#pragma unroll
            for (int s = 0; s < 4; ++s) kf[s] = *(const LAS bf16x8*)(lds + MEMK_OFF + ((T0 + t) * 32 + krow) * KPITCH + (s4 + s) * 32 + hf * 16);
#pragma unroll
            for (int s = 0; s < 4; ++s) S[t] = __builtin_amdgcn_mfma_f32_32x32x16_bf16(kf[s], qf[s4 + s], S[t], 0, 0, 0);
        }
    }
    float mx = -__builtin_inff();
#pragma unroll
    for (int t = 0; t < 4; ++t)
#pragma unroll
        for (int v = 0; v < 16; ++v) { S[t][v] *= SCL2; mx = fmaxf(mx, S[t][v]); }
    mx = fmaxf(mx, __shfl_xor(mx, 32));
    const float mn = FIRST ? mx : fmaxf(m, mx);
    if (FIRST) { l = 0.f;
#pragma unroll
        for (int dt = 0; dt < 4; ++dt)
#pragma unroll
            for (int v = 0; v < 16; ++v) o[dt][v] = 0.f;
    } else { const float corr = __builtin_amdgcn_exp2f(m - mn); l *= corr;
#pragma unroll
        for (int dt = 0; dt < 4; ++dt)
#pragma unroll
            for (int v = 0; v < 16; ++v) o[dt][v] *= corr; }
    m = mn;
    float ps = 0.f;
#pragma unroll
    for (int t = 0; t < 4; ++t) {
        float p[16];
#pragma unroll
        for (int v = 0; v < 16; ++v) { p[v] = __builtin_amdgcn_exp2f(S[t][v] - mn); ps += p[v]; }
#pragma unroll
        for (int s = 0; s < 2; ++s) {
            typedef unsigned u32x4v __attribute__((ext_vector_type(4)));
            u32x4v pw; pw.x = pk_bf16(p[8 * s + 0], p[8 * s + 1]); pw.y = pk_bf16(p[8 * s + 2], p[8 * s + 3]); pw.z = pk_bf16(p[8 * s + 4], p[8 * s + 5]); pw.w = pk_bf16(p[8 * s + 6], p[8 * s + 7]);
            const bf16x8 pf = __builtin_bit_cast(bf16x8, pw);
            bf16x8 vf[4];
#pragma unroll
            for (int dt = 0; dt < 4; ++dt) vf[dt] = *(const LAS bf16x8*)(lds + MEMV_OFF + (dt * 32 + c) * MVPITCH + ((T0 + t) * 32 + s * 16 + hf * 8) * 2);
#pragma unroll
            for (int dt = 0; dt < 4; ++dt) o[dt] = __builtin_amdgcn_mfma_f32_32x32x16_bf16(vf[dt], pf, o[dt], 0, 0, 0);
        }
    }
    l += ps;
}
__device__ __forceinline__ void memattn_task(const bf16_t* h, int ldh, int qoff, int tok0, int hh, unsigned char* mixq, int lane, LAS unsigned char* lds, LAS unsigned char* ws) {
    bf16x8 qf[8];
    {
        const char* qb = (const char*)(h + (size_t)tok0 * ldh + qoff + hh * HD);
        rawv raw[8];
#pragma unroll
        for (int i = 0; i < 8; ++i) raw[i] = *(const rawv*)(qb + (size_t)(4 * i + (lane >> 4)) * ldh * 2 + (lane & 15) * 16);
        const int c = lane & 31, hf = lane >> 5;
#pragma unroll
        for (int s = 0; s < 8; ++s) qf[s] = (bf16x8){0, 0, 0, 0, 0, 0, 0, 0};
#pragma unroll
        for (int ps = 0; ps < 4; ++ps) {
            *(LAS rawv*)(ws + (lane >> 4) * KPITCH + (lane & 15) * 16) = raw[2 * ps]; *(LAS rawv*)(ws + (4 + (lane >> 4)) * KPITCH + (lane & 15) * 16) = raw[2 * ps + 1];
            ATT_WSYNC();
#pragma unroll
            for (int s = 0; s < 8; ++s) { const bf16x8 t = *(const LAS bf16x8*)(ws + (c & 7) * KPITCH + s * 32 + hf * 16); if ((c >> 3) == ps) qf[s] = t; }
            ATT_WSYNC();
        }
    }
    float m = -__builtin_inff(), l = 0.f; f32x16 o[4];
    memattn_chunk<true>(qf, 0, m, l, o, lane, lds);
    memattn_chunk<false>(qf, 4, m, l, o, lane, lds);
    attn_store_q(o, l, mixq + (size_t)tok0 * DM + LOCALW + hh * HD, (size_t)DM, lane, ws);
}

constexpr int LDS_TICK_OFF = MEM_LDS_END + 8 * 2304 + 8;
template <bool DIL>
__device__ __forceinline__ void attn_phase(const bf16_t* h, int ldh, int qoff, const bf16_t* vtd, const bf16_t* kmat, const bf16_t* vtm, int layer, bf16_t* mix, unsigned char* mixq, LAS unsigned char* lds) {
    const int tid = otid(), bid = obid(); const int lane0 = tid & 63, wv = tid >> 6;
    LAS float* lseb = (LAS float*)lds;
    LAS unsigned char* wb = lds + 6144 + wv * WBUF;
    for (int bt = bid; bt < 256; bt += gridDim.x) {
        const int pi = (bt & 7) * 4 + (bt >> 6), c8 = (bt >> 3) & 7, b = pi >> 2, hh = pi & 3;
        const int tokb = b * SEQ + c8 * 512;
        if (DIL) {
            volatile LAS unsigned* tick = (volatile LAS unsigned*)(lds + LDS_TICK_OFF);
            if (tid == 0) *tick = 0u;
            __syncthreads();
            for (;;) {
                unsigned wt_ = 0u; if (lane0 == 0) wt_ = __hip_atomic_fetch_add((LAS unsigned*)(lds + LDS_TICK_OFF), 1u, __ATOMIC_RELAXED, __HIP_MEMORY_SCOPE_WORKGROUP);
                const int wt = (int)__builtin_amdgcn_readfirstlane(wt_);
                if (wt >= 48) break;
                int lane = lane0; asm volatile("" : "+v"(lane));
                const int g = wt >> 4, idx = wt & 15;
                const int dil = g == 0 ? 1 : (g == 1 ? 4 : 16), Lg = SEQ / dil;
                const int r = g == 0 ? 0 : (g == 1 ? (idx >> 2) : idx), tile = g == 0 ? idx : (g == 1 ? (idx & 3) : 0);
                const int i0 = c8 * (512 / dil) + tile * 32;
                const size_t rs = (size_t)dil * ldh;
                const bf16_t* base = h + (size_t)(b * SEQ + r) * ldh + g * 512 + hh * HD;
                bf16x8 qf[8]; attn_load_q(qf, base + (size_t)i0 * rs, rs, lane, wb);
                const bf16_t* kp = base + LOCALW + (long long)(i0 - 128) * (long long)rs;
                const bf16_t* vp = vtd + (size_t)g * 512 * NT + ((long long)(b * SEQ + r * Lg + i0 - 128) / 32) * 16384 + hh * HD * 32;
                int t_lo = (128 - i0) / 32; t_lo = t_lo < 0 ? 0 : t_lo;
                float m = -__builtin_inff(), l = 0.f; f32x16 o[4];
                attn_chunk<5, true>(qf, kp, rs, vp, (size_t)32, t_lo, true, true, m, l, o, lane, wb);
                const int tl = r + dil * (tile * 32);
                const float lse = attn_store8(o, m, l, mixq + (size_t)(tokb + tl) * DM + g * 512 + hh * HD, (size_t)dil * DM, lane, wb);
                if (lane < 32) lseb[g * 512 + tl + dil * lane] = lse;
            }
        }
        {
            int tz = tid; asm volatile("" : "+v"(tz));
            __syncthreads();
            memattn_fill(kmat, vtm, layer, b, hh, lds, tz);
            __syncthreads();
            for (int wt = wv; wt < 16; wt += NWAVE) { int lane = lane0; asm volatile("" : "+v"(lane)); memattn_task(h, ldh, qoff, tokb + wt * 32, hh, mixq, lane, lds, lds + MEM_LDS_END + wv * 2304); }
            if (!DIL) __syncthreads();
        }
        if (DIL) {
            asm volatile("s_waitcnt vmcnt(0)" ::: "memory");
            __syncthreads();
            for (int e = tid; e < 512 * 48; e += NTHR) {
                const int tk = e / 48, rem = e % 48, g = rem >> 4, pc = rem & 15;
                const float l0 = lseb[tk], l1 = lseb[512 + tk], l2 = lseb[1024 + tk];
                const float mx = fmaxf(l0, fmaxf(l1, l2));
                const float e0 = __builtin_amdgcn_exp2f(l0 - mx), e1 = __builtin_amdgcn_exp2f(l1 - mx), e2 = __builtin_amdgcn_exp2f(l2 - mx);
                const float al = (g == 0 ? e0 : (g == 1 ? e1 : e2)) / (e0 + e1 + e2);
                const size_t off = (size_t)(tokb + tk) * DM + g * 512 + hh * HD + pc * 8;
                const uint2 v = *(const uint2*)(mixq + off);
                const f32x2 a0 = __builtin_amdgcn_cvt_pk_f32_fp8((int)v.x, false), a1 = __builtin_amdgcn_cvt_pk_f32_fp8((int)v.x, true), a2 = __builtin_amdgcn_cvt_pk_f32_fp8((int)v.y, false), a3 = __builtin_amdgcn_cvt_pk_f32_fp8((int)v.y, true);
                uint2 w; w.x = pk4_e4m3(a0.x * al, a0.y * al, a1.x * al, a1.y * al); w.y = pk4_e4m3(a2.x * al, a2.y * al, a3.x * al, a3.y * al);
                *(uint2*)(mixq + off) = w;
            }
            __syncthreads();
        }
    }
}

__device__ __forceinline__ void ln_phase(float* y, const float* gam, const float* bet, bf16_t* xb) {
    const int tid = otid(), bid = obid(); const int lane = tid & 63; const int wave = bid * NWAVE + (tid >> 6), nw = gridDim.x * NWAVE;
    for (int row = wave; row < NT; row += nw) {
        float4 v[8]; float s = 0.f;
#pragma unroll
        for (int c = 0; c < 8; ++c) { v[c] = *(const float4*)(y + (size_t)row * DM + c * 256 + lane * 4); s += (v[c].x + v[c].y) + (v[c].z + v[c].w); }
        const float mean = wave_sum(s) * (1.0f / DM); float q = 0.f;
#pragma unroll
        for (int c = 0; c < 8; ++c) { const float a = v[c].x - mean, b = v[c].y - mean, cc = v[c].z - mean, d = v[c].w - mean; q += (a * a + b * b) + (cc * cc + d * d); }
        const float rstd = rsqrtf(wave_sum(q) * (1.0f / DM) + LN_EPS);
#pragma unroll
        for (int c = 0; c < 8; ++c) {
            const int col = c * 256 + lane * 4; const float4 g4 = *(const float4*)(gam + col), b4 = *(const float4*)(bet + col);
            float4 o; o.x = (v[c].x - mean) * rstd * g4.x + b4.x; o.y = (v[c].y - mean) * rstd * g4.y + b4.y; o.z = (v[c].z - mean) * rstd * g4.z + b4.z; o.w = (v[c].w - mean) * rstd * g4.w + b4.w;
            *(float4*)(y + (size_t)row * DM + col) = o;
            uint2 pk; pk.x = pk_bf16(o.x, o.y); pk.y = pk_bf16(o.z, o.w); *(uint2*)(xb + (size_t)row * DM + col) = pk;
        }
    }
}

__device__ __forceinline__ void tk_insert(float (&L)[16], float x) {
#pragma unroll
    for (int i = 15; i >= 1; --i) L[i] = __builtin_amdgcn_fmed3f(L[i - 1], L[i], x);
    L[0] = fmaxf(L[0], x);
}
#define WAVE_SYNC() do { __builtin_amdgcn_fence(__ATOMIC_RELEASE, "wavefront"); __builtin_amdgcn_wave_barrier(); __builtin_amdgcn_fence(__ATOMIC_ACQUIRE, "wavefront"); } while (0)
__device__ __forceinline__ float dot32_fp4(const f32x2 (&x2)[16], const uint4 u) {
    const unsigned w[4] = {u.x, u.y, u.z, u.w};
    f32x2 p = {0.f, 0.f}, q = {0.f, 0.f};
#pragma unroll
    for (int d = 0; d < 4; ++d) {
        const f32x2 t0 = __builtin_amdgcn_cvt_scalef32_pk_f32_fp4(w[d], 1.0f, 0), t1 = __builtin_amdgcn_cvt_scalef32_pk_f32_fp4(w[d], 1.0f, 1);
        const f32x2 t2 = __builtin_amdgcn_cvt_scalef32_pk_f32_fp4(w[d], 1.0f, 2), t3 = __builtin_amdgcn_cvt_scalef32_pk_f32_fp4(w[d], 1.0f, 3);
        p = x2[4 * d + 0] * t0 + p; q = x2[4 * d + 1] * t1 + q; p = x2[4 * d + 2] * t2 + p; q = x2[4 * d + 3] * t3 + q; }
    p = p + q;
    return p.x + p.y;
}
__device__ __forceinline__ void axpy32_fp4(f32x2 (&acc)[16], float w_, const uint4 u) {
    const unsigned w[4] = {u.x, u.y, u.z, u.w};
    const f32x2 ww = {w_, w_};
#pragma unroll
    for (int d = 0; d < 4; ++d) {
        const f32x2 t0 = __builtin_amdgcn_cvt_scalef32_pk_f32_fp4(w[d], 1.0f, 0), t1 = __builtin_amdgcn_cvt_scalef32_pk_f32_fp4(w[d], 1.0f, 1);
        const f32x2 t2 = __builtin_amdgcn_cvt_scalef32_pk_f32_fp4(w[d], 1.0f, 2), t3 = __builtin_amdgcn_cvt_scalef32_pk_f32_fp4(w[d], 1.0f, 3);
        acc[4 * d + 0] = ww * t0 + acc[4 * d + 0]; acc[4 * d + 1] = ww * t1 + acc[4 * d + 1]; acc[4 * d + 2] = ww * t2 + acc[4 * d + 2]; acc[4 * d + 3] = ww * t3 + acc[4 * d + 3]; }
}
__device__ __forceinline__ float reduce4(float p0, float p1, float p2, float p3, int lane) {
    const bool b5 = (lane & 32) != 0, b4 = (lane & 16) != 0;
    float s0 = b5 ? p2 : p0, s1 = b5 ? p3 : p1; const float t0 = b5 ? p0 : p2, t1 = b5 ? p1 : p3;
    s0 += __shfl_xor(t0, 32); s1 += __shfl_xor(t1, 32);
    float k = b4 ? s1 : s0; const float t = b4 ? s0 : s1; k += __shfl_xor(t, 16);
    k += __shfl_xor(k, 8); k += __shfl_xor(k, 4); k += __shfl_xor(k, 2); k += __shfl_xor(k, 1);
    return k;
}
typedef float lf4v __attribute__((ext_vector_type(4)));
typedef unsigned lu2v __attribute__((ext_vector_type(2)));
__device__ __forceinline__ float4 lds_ld4(const LAS float* p) { const lf4v t = *(const LAS lf4v*)p; return make_float4(t[0], t[1], t[2], t[3]); }
__device__ __forceinline__ void lds_st4(LAS float* p, const float4 v) { *(LAS lf4v*)p = (lf4v){v.x, v.y, v.z, v.w}; }
__device__ __forceinline__ uint2 lds_ldu2(const LAS unsigned short* p) { const lu2v t = *(const LAS lu2v*)p; uint2 r; r.x = t[0]; r.y = t[1]; return r; }
__device__ __forceinline__ void lds_stu2(LAS unsigned short* p, const uint2 v) { *(LAS lu2v*)p = (lu2v){v.x, v.y}; }
__device__ __forceinline__ void peer_phase(const bf16_t* ybf, bf16_t* xres, float* fout, const _Float16* scores, const float* cs, const float* bw, const float* lg1, const float* lb1, const unsigned char* U8, const unsigned char* V8, const float* gam, const float* bet, unsigned char* xq, const float* part, LAS unsigned char* lds) {
    const int tid = otid(), bid = obid(); const int lane = tid & 63, wv = tid >> 6; const int wave = bid * NWAVE + wv, nw = gridDim.x * NWAVE;
    LAS float* vbuf = (LAS float*)(lds + wv * 12544);
    LAS int* ebuf = (LAS int*)(lds + wv * 12544 + 4352);
    LAS float* gbuf = (LAS float*)(lds + wv * 12544 + 6400);
    LAS unsigned short* ybuf = (LAS unsigned short*)(lds + wv * 12544 + 8448);
    LAS float* pl = (LAS float*)(lds + 8 * 12544);
    {
        const float* srcs[6] = {lg1, lb1, gam, bet, cs, bw};
#pragma unroll
        for (int v = 0; v < 6; ++v) lds_st4(pl + v * 2048 + tid * 4, *(const float4*)(srcs[v] + tid * 4));
        __syncthreads();
    }
    for (int tok0 = wave * 4; tok0 < NT; tok0 += nw * 4) {
        float mu4[4], rs4[4];
        {
            const float4 pv = *(const float4*)(part + ((size_t)(tok0 + (lane >> 4)) * 32 + (lane & 15) * 2) * 2);
            float s = pv.x + pv.z, q = pv.y + pv.w;
#pragma unroll
            for (int o = 1; o <= 8; o <<= 1) { s += __shfl_xor(s, o); q += __shfl_xor(q, o); }
            const float mean = s * (1.0f / DM); const float rsd = rsqrtf(fmaxf(q * (1.0f / DM) - mean * mean, 0.f) + LN_EPS);
#pragma unroll
            for (int ti = 0; ti < 4; ++ti) { mu4[ti] = __builtin_bit_cast(float, __builtin_amdgcn_readlane(__builtin_bit_cast(int, mean), ti * 16)); rs4[ti] = __builtin_bit_cast(float, __builtin_amdgcn_readlane(__builtin_bit_cast(int, rsd), ti * 16)); }
        }
        {
            const int tl = lane >> 4;
            const float rs = tl == 0 ? rs4[0] : (tl == 1 ? rs4[1] : (tl == 2 ? rs4[2] : rs4[3]));
            const float nm = -rs * (tl == 0 ? mu4[0] : (tl == 1 ? mu4[1] : (tl == 2 ? mu4[2] : mu4[3])));
            const _Float16* s = scores + (size_t)(tok0 >> 2) * 8192 + ((lane & 15) * 4 + tl) * 4;
            const LAS float* cp = pl + 8192 + (lane & 15) * 4; const LAS float* bp = pl + 10240 + (lane & 15) * 4;
            float L[16];
#pragma unroll
            for (int i = 0; i < 16; ++i) L[i] = -__builtin_inff();
#pragma unroll 1
            for (int n0 = 0; n0 < 128; n0 += 32) {
                float4 sv[8], cv[8], bv[8];
#pragma unroll
                for (int u = 0; u < 8; ++u) { const int nch = (n0 >> 2) + u; { typedef _Float16 f16x4 __attribute__((ext_vector_type(4))); const f16x4 hv = *(const f16x4*)(s + nch * 256); sv[u] = make_float4((float)hv[0], (float)hv[1], (float)hv[2], (float)hv[3]); } cv[u] = lds_ld4(cp + nch * 64); bv[u] = lds_ld4(bp + nch * 64); }
                __builtin_amdgcn_sched_barrier(0);
#pragma unroll
                for (int u = 0; u < 8; ++u) {
                    const int n = n0 + 4 * u; float4 v = sv[u]; const float4 c4 = cv[u], b4 = bv[u];
                    v.x = rs * v.x + (nm * c4.x + b4.x); v.y = rs * v.y + (nm * c4.y + b4.y); v.z = rs * v.z + (nm * c4.z + b4.z); v.w = rs * v.w + (nm * c4.w + b4.w);
                    tk_insert(L, __uint_as_float((__float_as_uint(v.x) & ~127u) | (unsigned)(n + 0)));
                    tk_insert(L, __uint_as_float((__float_as_uint(v.y) & ~127u) | (unsigned)(n + 1)));
                    tk_insert(L, __uint_as_float((__float_as_uint(v.z) & ~127u) | (unsigned)(n + 2)));
                    tk_insert(L, __uint_as_float((__float_as_uint(v.w) & ~127u) | (unsigned)(n + 3)));
                }
            }
#pragma unroll
            for (int i = 0; i < 16; ++i) vbuf[lane * 17 + i] = L[i];
        }
        WAVE_SYNC();
        if (lane < 32) {
            const int b1 = ((lane >> 3) * 16 + 2 * (lane & 7)) * 17, b2 = b1 + 17;
            float v1[16], v2[16], M[16];
#pragma unroll
            for (int i = 0; i < 16; ++i) { v1[i] = vbuf[b1 + i]; v2[i] = vbuf[b2 + i]; M[i] = -__builtin_inff(); }
#pragma unroll
            for (int a = 0; a < 16; ++a)
#pragma unroll
                for (int b = 0; b < 16; ++b)
                    if ((a + 1) * (b + 1) <= 16) tk_insert(M, __uint_as_float((__float_as_uint(v1[a] + v2[b]) & ~255u) | (unsigned)(a * 16 + b)));
            float e[16], sum = 0.f;
#pragma unroll
            for (int k = 0; k < 16; ++k) { e[k] = __expf(M[k] - M[0]); sum += e[k]; }
            const float inv = 1.0f / sum;
#pragma unroll
            for (int k = 0; k < 16; ++k) {
                const unsigned code = __float_as_uint(M[k]) & 255u; const int a = code >> 4, b = code & 15;
                const unsigned i1 = __float_as_uint(vbuf[b1 + a]) & 127u, i2 = __float_as_uint(vbuf[b2 + b]) & 127u;
                ebuf[lane * 16 + k] = (int)(i1 * 128u + i2);
                gbuf[lane * 16 + k] = e[k] * inv;
            }
        }
        WAVE_SYNC();
        for (int ti = 0; ti < 4; ++ti) {
            const int tok = tok0 + ti;
            int ln = lane; asm volatile("" : "+v"(ln));
            unsigned vo16 = (unsigned)ln * 16u, vo2 = (unsigned)ln * 2u; asm volatile("" : "+v"(vo16), "+v"(vo2));
            const int e0 = ebuf[ti * 128 + ln], e1 = ebuf[ti * 128 + 64 + ln]; const float g0 = gbuf[ti * 128 + ln], g1 = gbuf[ti * 128 + 64 + ln];
#define ROW_LOAD(TBL, QB, SB, K0) do { unsigned v16_ = vo16, v2_ = vo2; asm volatile("" : "+v"(v16_), "+v"(v2_)); _Pragma("unroll") for (int j_ = 0; j_ < 8; ++j_) { \
                const int e_ = __builtin_amdgcn_readlane((K0) < 64 ? e0 : e1, ((K0) + j_) & 63); \
                unsigned ro_; asm volatile("s_mul_i32 %0, %1, %2" : "=s"(ro_) : "s"(e_), "s"((int)ROWB));        \
                const unsigned char* r_ = (TBL) + ro_; \
                QB[j_] = *(const uint4*)(r_ + v16_); SB[j_] = *(const unsigned short*)(r_ + v2_ + 1024); } } while (0)
#define U_COMPUTE(QB, SB, K0) do { f32x4p d_[8]; _Pragma("unroll") for (int j_ = 0; j_ < 8; ++j_) { \
                    i32x8p a_; a_[0] = (int)QB[j_].x; a_[1] = (int)QB[j_].y; a_[2] = (int)QB[j_].z; a_[3] = (int)QB[j_].w; a_[4] = 0; a_[5] = 0; a_[6] = 0; a_[7] = 0; \
                    d_[j_] = __builtin_amdgcn_mfma_scale_f32_16x16x128_f8f6f4(a_, xb, (f32x4p){0.f, 0.f, 0.f, 0.f}, 4, 0, 0, (int)((unsigned)SB[j_] >> 7), 0, 0x7f7f7f7f); } \
                __builtin_amdgcn_sched_barrier(0); \
                float pj_[8]; _Pragma("unroll") for (int j_ = 0; j_ < 8; ++j_) { \
                    const float mt_ = __uint_as_float((((unsigned)SB[j_] & 0x7fu) << 16) | 0x3f800000u); \
                    pj_[j_] = (d_[j_][0] * dm0 + d_[j_][1] * dm1 + d_[j_][2] * dm2 + d_[j_][3] * dm3) * mt_; } \
                const float r0_ = reduce4(pj_[0], pj_[1], pj_[2], pj_[3], ln), r1_ = reduce4(pj_[4], pj_[5], pj_[6], pj_[7], ln); \
                _Pragma("unroll") for (int j_ = 0; j_ < 8; ++j_) { \
                    const float aj_ = __builtin_bit_cast(float, __builtin_amdgcn_readlane(__builtin_bit_cast(int, j_ < 4 ? r0_ : r1_), 16 * (j_ & 3))); \
                    if (ln == (((K0) + j_) & 63)) { if ((K0) < 64) a0 = aj_; else a1 = aj_; } } } while (0)
#define V_COMPUTE(QB, SB, K0) do { _Pragma("unroll") for (int j_ = 0; j_ < 8; ++j_) { \
                const float wk_ = __builtin_bit_cast(float, __builtin_amdgcn_readlane(__builtin_bit_cast(int, (K0) < 64 ? w0 : w1), ((K0) + j_) & 63)); \
                axpy32_fp4(acc, wk_ * __uint_as_float((unsigned)SB[j_] << 16), QB[j_]); __builtin_amdgcn_sched_barrier(0); } } while (0)
#define SCHED_FENCE() __builtin_amdgcn_sched_barrier(0)
            float a0 = 0.f, a1 = 0.f;
            uint4 qa[8], qb[8]; unsigned short sa[8], sb2[8];
            ROW_LOAD(U8, qa, sa, 0); SCHED_FENCE();
            i32x8p xb;
            const float dm0 = ((ln & 15) - 4 * (ln >> 4)) == 0 ? 1.f : 0.f, dm1 = ((ln & 15) - 4 * (ln >> 4)) == 1 ? 1.f : 0.f, dm2 = ((ln & 15) - 4 * (ln >> 4)) == 2 ? 1.f : 0.f, dm3 = ((ln & 15) - 4 * (ln >> 4)) == 3 ? 1.f : 0.f;
            {
                const float mu = ti == 0 ? mu4[0] : (ti == 1 ? mu4[1] : (ti == 2 ? mu4[2] : mu4[3])), rs = ti == 0 ? rs4[0] : (ti == 1 ? rs4[1] : (ti == 2 ? rs4[2] : rs4[3]));
                const int xo = (ln & 15) * 4 + ((ln >> 5) & 1) * 64 + ((ln >> 4) & 1) * 1024;
#pragma unroll
                for (int r = 0; r < 8; ++r) { const int of = xo + (r & 3) * 256 + (r >> 2) * 128;
                    const uint2 yv = *(const uint2*)(ybf + (size_t)tok * DM + of); const float4 a = make_float4(bf_lo(yv.x), bf_hi(yv.x), bf_lo(yv.y), bf_hi(yv.y));
                    lds_stu2(ybuf + of, yv);
                    const float4 gg = lds_ld4(pl + of), bb = lds_ld4(pl + 2048 + of);
                    xb[r] = (int)pk4_e4m3((a.x - mu) * rs * gg.x + bb.x, (a.y - mu) * rs * gg.y + bb.y, (a.z - mu) * rs * gg.z + bb.z, (a.w - mu) * rs * gg.w + bb.w); }
            }
#pragma unroll 1
            for (int k = 0; k < 128; k += 16) {
                ROW_LOAD(U8, qb, sb2, k + 8); SCHED_FENCE();
                U_COMPUTE(qa, sa, k); SCHED_FENCE();
                if (k + 16 < 128) ROW_LOAD(U8, qa, sa, k + 16); else ROW_LOAD(V8, qa, sa, 0);
                SCHED_FENCE();
                U_COMPUTE(qb, sb2, k + 8); SCHED_FENCE();
            }
            const float w0 = g0 * 0.5f * a0 * (1.0f + erff(a0 * 0.70710678118654752f)), w1 = g1 * 0.5f * a1 * (1.0f + erff(a1 * 0.70710678118654752f));
            f32x2 acc[16];
#pragma unroll
            for (int i = 0; i < 16; ++i) acc[i] = (f32x2){0.f, 0.f};
#pragma unroll 1
            for (int k = 0; k < 128; k += 16) {
                ROW_LOAD(V8, qb, sb2, k + 8); SCHED_FENCE();
                V_COMPUTE(qa, sa, k); SCHED_FENCE();
                if (k + 16 < 128) { ROW_LOAD(V8, qa, sa, k + 16); }
                SCHED_FENCE();
                V_COMPUTE(qb, sb2, k + 8); SCHED_FENCE();
            }
            float s = 0.f;
            {
                int l2 = ln; asm volatile("" : "+v"(l2));
                const float mu = ti == 0 ? mu4[0] : (ti == 1 ? mu4[1] : (ti == 2 ? mu4[2] : mu4[3])), rs = ti == 0 ? rs4[0] : (ti == 1 ? rs4[1] : (ti == 2 ? rs4[2] : rs4[3]));
#pragma unroll
                for (int c = 0; c < 8; ++c) { const uint2 yv = lds_ldu2(ybuf + c * 256 + l2 * 4); const float4 a = make_float4(bf_lo(yv.x), bf_hi(yv.x), bf_lo(yv.y), bf_hi(yv.y));
                    const float4 gg = lds_ld4(pl + c * 256 + l2 * 4), bb = lds_ld4(pl + 2048 + c * 256 + l2 * 4);
                    acc[c * 2 + 0] += (f32x2){ALPHA * ((a.x - mu) * rs * gg.x + bb.x), ALPHA * ((a.y - mu) * rs * gg.y + bb.y)};
                    acc[c * 2 + 1] += (f32x2){ALPHA * ((a.z - mu) * rs * gg.z + bb.z), ALPHA * ((a.w - mu) * rs * gg.w + bb.w)};
                    s += (acc[c * 2 + 0].x + acc[c * 2 + 0].y) + (acc[c * 2 + 1].x + acc[c * 2 + 1].y); }
            }
            const float mean = wave_sum(s) * (1.0f / DM); float q = 0.f;
#pragma unroll
            for (int i = 0; i < 16; ++i) { const float d0 = acc[i].x - mean, d1 = acc[i].y - mean; q += d0 * d0 + d1 * d1; }
            const float rstd = rsqrtf(wave_sum(q) * (1.0f / DM) + LN_EPS);
#pragma unroll
            for (int c = 0; c < 8; ++c) {
                const int col = c * 256 + ln * 4; const float4 ga = lds_ld4(pl + 4096 + col), ba = lds_ld4(pl + 6144 + col);
                float4 oa; oa.x = (acc[c * 2 + 0].x - mean) * rstd * ga.x + ba.x; oa.y = (acc[c * 2 + 0].y - mean) * rstd * ga.y + ba.y;
                oa.z = (acc[c * 2 + 1].x - mean) * rstd * ga.z + ba.z; oa.w = (acc[c * 2 + 1].y - mean) * rstd * ga.w + ba.w;
                if (fout) *(float4*)(fout + (size_t)tok * DM + col) = oa;
                else { { uint2 xb2; xb2.x = pk_bf16(oa.x, oa.y); xb2.y = pk_bf16(oa.z, oa.w); *(uint2*)(xres + (size_t)tok * DM + col) = xb2; }
                       *(unsigned*)(xq + (size_t)tok * DM + col) = pk4_e4m3(oa.x, oa.y, oa.z, oa.w); }
            }
        }
        WAVE_SYNC();
    }
}


__device__ __forceinline__ void table_slot(const Params& p, int l, int ph) {
    const int lo = ph == 0 ? 0 : (ph == 1 ? 10923 : 21846), hi = ph == 0 ? 10923 : (ph == 1 ? 21846 : 2 * NEXP);
    const int ulo = lo < NEXP ? lo : NEXP, uhi = hi < NEXP ? hi : NEXP, vlo = (lo > NEXP ? lo : NEXP) - NEXP, vhi = (hi > NEXP ? hi : NEXP) - NEXP;
    if (uhi > ulo) quant_phase<true>(p.peer_u + ((size_t)l * NEXP + ulo) * DM, p.U8 + ((size_t)l * NEXP + ulo) * ROWB, uhi - ulo);
    if (vhi > vlo) quant_phase<false>(p.peer_v + ((size_t)l * NEXP + vlo) * DM, p.V8 + ((size_t)l * NEXP + vlo) * ROWB, vhi - vlo);
}
constexpr int FP8_SCORE_FROM = 0;
constexpr int PEER_LDS_END = 8 * 12544 + 6 * 8192;
constexpr int MEM_SCR_END = MEM_LDS_END + 8 * 2304;
constexpr int LDS_MAIN0 = (MEM_SCR_END > pg8::STAGE_BYTES ? MEM_SCR_END : pg8::STAGE_BYTES);
constexpr int LDS_MAIN = LDS_MAIN0 > PEER_LDS_END ? LDS_MAIN0 : PEER_LDS_END;
constexpr int LDS_TOTAL = LDS_MAIN + 16;
static_assert(LDS_TICK_OFF == LDS_MAIN + 8, "ticket word must sit in the control words behind the main LDS region");
__global__ __launch_bounds__(512, 2) void mega(Params p) {
    extern __shared__ __attribute__((aligned(16))) unsigned char shm[];
    LAS unsigned char* lds = (LAS unsigned char*)shm;
    volatile LAS unsigned* xb_words = (volatile LAS unsigned*)(lds + LDS_MAIN);
    if (threadIdx.x < 4) xb_words[threadIdx.x] = 0u;
    __syncthreads();
    XcdBarrier bar = xcd_barrier_post(p.bar, xb_words);
    const size_t WSQ = (size_t)DM * DM;
    const int G = (int)gridDim.x, c = (int)blockIdx.x;

    prologue_phase(p, lds);
    xcd_barrier(bar);
    {
        const int gt = obid() * NTHR + otid();
        if (gt < DEPTH * DM) { float a = 0.f, b = 0.f;
            for (int t = 0; t < 32; ++t) { a += p.pcs[(size_t)gt * 32 + t]; b += p.pbw[(size_t)gt * 32 + t]; }
            const int ly = gt >> 11, col = gt & 2047, hp = col >> 7, n = col & 127, pi = ly * DM + ((n >> 2) * 16 + hp) * 4 + (n & 3);
            p.cs[pi] = a; p.bw[pi] = b; } }
    {
        pg8::Gemm g; g.A = p.membf; g.Bt = p.wt_k; g.M = NB_ * NMEM; g.N = 2048; g.K = DM; g.bdil = 1;
        pg8::StaticOrder S; S.init(g.M, g.N, G, c); pg8::EpiBf16 E; E.O = p.kmat; E.cscale = nullptr; E.rscale = nullptr; E.ldc = KVLD; E.pad = 0;
        pg8::gemm_phase<pg8::EpiBf16, pg8::StaticOrder>(lds, g, S, E);
        g.A = p.wt_v; g.Bt = p.membf; E.O = p.vtm; S.init(g.M, g.N, G, (c + 64) % G);
        pg8::gemm_phase<pg8::EpiBf16, pg8::StaticOrder>(lds, g, S, E); }
    {
        wquant_rows(p.wt_in0, p.wq_in0, p.sc_in + 0 * 5120, 2048); wquant_rows(p.wt_in1, p.wq_in1, p.sc_in + 1 * 5120, 5120);
        wquant_rows(p.wt_in2, p.wq_in2, p.sc_in + 2 * 5120, 2048); wquant_rows(p.wt_in3, p.wq_in3, p.sc_in + 3 * 5120, 5120);
        wquant_rows(p.wt_o, p.wq_o, p.sc_o, DEPTH * DM); wquant_rows(p.wt_s + (size_t)FP8_SCORE_FROM * WSQ, p.wq_s + (size_t)FP8_SCORE_FROM * WSQ, p.sc_s + FP8_SCORE_FROM * DM, (DEPTH - FP8_SCORE_FROM) * DM); }
    xcd_barrier(bar);
    for (int l = 0; l < DEPTH; ++l) {
        const bool pool = (l & 1) == 0; const int ldh = pool ? DM : 3584;
        const unsigned char* wq_in = l == 0 ? p.wq_in0 : (l == 1 ? p.wq_in1 : (l == 2 ? p.wq_in2 : p.wq_in3));
        const float* sc_in = p.sc_in + (size_t)l * 5120;
        const bool late = ((obid() >> 3) & 1) == 0;
        if (!late) table_slot(p, l, 0);
        { pg8::Gemm g; g.A = (const bf16_t*)p.xq; g.Bt = (const bf16_t*)wq_in; g.M = NT; g.N = ldh; g.K = DM; g.bdil = 1;
          pg8::StaticOrder S; S.init(g.M, g.N, G, c); pg8::EpiBf16 E; E.O = p.h; E.cscale = sc_in; E.rscale = nullptr; E.ldc = ldh; E.pad = 0;
          pg8::gemm_phase<pg8::EpiBf16, pg8::StaticOrder, true>(lds, g, S, E);
          if (!pool) {
              for (int gi = 0; gi < 3; ++gi) {
                  g.A = (const bf16_t*)(wq_in + (size_t)(3584 + gi * 512) * DM); g.Bt = (const bf16_t*)p.xq; g.M = 512; g.N = NT; g.bdil = gi == 0 ? 1 : (gi == 1 ? 4 : 16);
                  S.init(g.M, g.N, G, c); E.O = p.vtd + (size_t)gi * 512 * NT; E.cscale = nullptr; E.rscale = sc_in + 3584 + gi * 512; E.ldc = VTLD; E.blk = 1;
                  pg8::gemm_phase<pg8::EpiBf16, pg8::StaticOrder, true>(lds, g, S, E); } } }
        if (late) table_slot(p, l, 0);
        xcd_barrier(bar);
        if (pool) { pool_phase(p.h, p.mixq); attn_phase<false>(p.h, ldh, ldh - MEMW, p.vtd, p.kmat, p.vtm, l, p.mix, p.mixq, lds); }
        else attn_phase<true>(p.h, ldh, ldh - MEMW, p.vtd, p.kmat, p.vtm, l, p.mix, p.mixq, lds);
        xcd_barrier(bar);
        if (!late) table_slot(p, l, 1);
        if (l >= FP8_SCORE_FROM) {
        { pg8::Gemm g; g.A = (const bf16_t*)p.mixq; g.Bt = (const bf16_t*)(p.wq_o + (size_t)l * WSQ); g.M = NT; g.N = DM; g.K = DM; g.bdil = 1;
          pg8::StaticOrder S; S.init(g.M, g.N, G, c); pg8::EpiResT<true> E; E.R = p.xres; E.Yb = p.xbf; E.cscale = p.sc_o + (size_t)l * DM; E.ldc = DM; E.alpha = ALPHA; E.part = p.part; E.Yq = p.yq;
          pg8::gemm_phase<pg8::EpiResT<true>, pg8::StaticOrder, true>(lds, g, S, E); }
        } else {
        { pg8::Gemm g; g.A = (const bf16_t*)p.mixq; g.Bt = (const bf16_t*)(p.wq_o + (size_t)l * WSQ); g.M = NT; g.N = DM; g.K = DM; g.bdil = 1;
          pg8::StaticOrder S; S.init(g.M, g.N, G, c); pg8::EpiResT<false> E; E.R = p.xres; E.Yb = p.xbf; E.cscale = p.sc_o + (size_t)l * DM; E.ldc = DM; E.alpha = ALPHA; E.part = p.part; E.Yq = p.yq;
          pg8::gemm_phase<pg8::EpiResT<false>, pg8::StaticOrder, true>(lds, g, S, E); }
        }
        if (late) table_slot(p, l, 1);
        xcd_barrier(bar);
        if (!late) table_slot(p, l, 2);
        if (l >= FP8_SCORE_FROM) {
        { pg8::Gemm g; g.A = (const bf16_t*)p.yq; g.Bt = (const bf16_t*)(p.wq_s + (size_t)l * WSQ); g.M = NT; g.N = DM; g.K = DM; g.bdil = 1;
          pg8::StaticOrder S; S.init(g.M, g.N, G, c); pg8::EpiF32 E; E.C = (_Float16*)p.h; E.ldc = DM; E.pad = 0; E.cscale = p.sc_s + (size_t)l * DM;
          pg8::gemm_phase<pg8::EpiF32, pg8::StaticOrder, true>(lds, g, S, E); }
        } else {
        { pg8::Gemm g; g.A = p.xbf; g.Bt = p.wt_s + (size_t)l * WSQ; g.M = NT; g.N = DM; g.K = DM; g.bdil = 1;
          pg8::StaticOrder S; S.init(g.M, g.N, G, c); pg8::EpiF32 E; E.C = (_Float16*)p.h; E.ldc = DM; E.pad = 0;
          pg8::gemm_phase<pg8::EpiF32, pg8::StaticOrder>(lds, g, S, E); }
        }
        if (late) table_slot(p, l, 2);
        xcd_barrier(bar);
        peer_phase(p.xbf, p.xres, l == DEPTH - 1 ? p.out : nullptr, (const _Float16*)p.h, p.cs + (size_t)l * DM, p.bw + (size_t)l * DM, p.ln_g + (size_t)(l * 2) * DM, p.ln_b + (size_t)(l * 2) * DM, p.U8 + (size_t)l * NEXP * ROWB, p.V8 + (size_t)l * NEXP * ROWB, p.ln_g + (size_t)(l * 2 + 1) * DM, p.ln_b + (size_t)(l * 2 + 1) * DM, p.xq, p.part, lds);
        xcd_barrier(bar);
    }
}

constexpr size_t MB = 1024ull * 1024ull;
constexpr size_t OFF_WT_IN0 = 1 * MB;
constexpr size_t OFF_WT_IN1 = OFF_WT_IN0 + 8 * MB;
constexpr size_t OFF_WT_IN2 = OFF_WT_IN1 + 20 * MB;
constexpr size_t OFF_WT_IN3 = OFF_WT_IN2 + 8 * MB;
constexpr size_t OFF_WT_KV  = OFF_WT_IN3 + 20 * MB;
constexpr size_t OFF_WT_O   = OFF_WT_KV + 16 * MB;
constexpr size_t OFF_WT_S   = OFF_WT_O + 32 * MB;
constexpr size_t OFF_MEMBF  = OFF_WT_S + 32 * MB;
constexpr size_t OFF_KV     = OFF_MEMBF + 8 * MB;
constexpr size_t OFF_U      = OFF_KV + 18 * MB;
constexpr size_t OFF_V      = OFF_U + 128 * MB;
constexpr size_t OFF_SU     = OFF_V + 128 * MB;
constexpr size_t OFF_SV     = OFF_SU + 1 * MB;
constexpr size_t OFF_XBF    = OFF_SV + 1 * MB;
constexpr size_t OFF_H      = OFF_XBF + 128 * MB;
constexpr size_t OFF_MIX    = OFF_H + 321 * MB;
constexpr size_t OFF_XQ     = OFF_MIX + 128 * MB;
constexpr size_t OFF_MIXQ   = OFF_XQ + 64 * MB;
constexpr size_t OFF_WQ     = OFF_MIXQ + 64 * MB;
constexpr size_t OFF_XRES   = OFF_WQ + 46 * MB;
constexpr size_t OFF_YQ     = OFF_XRES + 128 * MB;
constexpr size_t OFF_WQS    = OFF_YQ + 64 * MB;
constexpr size_t WS_NEED    = OFF_WQS + 17 * MB;

extern "C" void kernel_launch(void* const* d_in, const int* in_sizes, int n_in, void* d_out, int out_size, void* d_ws, size_t ws_size, hipStream_t stream) {
    if (ws_size < WS_NEED) return;
    char* ws = (char*)d_ws;
    Params p{};
    p.x = (const float*)d_in[0]; p.mem = (const float*)d_in[1]; p.w_in_a = (const float*)d_in[2]; p.w_pool = (const float*)d_in[3]; p.s_pool = (const float*)d_in[4];
    p.w_in_b = (const float*)d_in[5]; p.w_mem_kv = (const float*)d_in[6]; p.w_o = (const float*)d_in[7]; p.ln_g = (const float*)d_in[8]; p.ln_b = (const float*)d_in[9];
    p.peer_wq = (const float*)d_in[10]; p.peer_keys = (const float*)d_in[11]; p.peer_u = (const float*)d_in[12]; p.peer_v = (const float*)d_in[13];
    p.out = (float*)d_out; p.bar = (unsigned*)ws;
    p.wt_in0 = (bf16_t*)(ws + OFF_WT_IN0); p.wt_in1 = (bf16_t*)(ws + OFF_WT_IN1); p.wt_in2 = (bf16_t*)(ws + OFF_WT_IN2); p.wt_in3 = (bf16_t*)(ws + OFF_WT_IN3);
    p.wt_k = (bf16_t*)(ws + OFF_WT_KV); p.wt_v = (bf16_t*)(ws + OFF_WT_KV + 8 * MB); p.wt_o = (bf16_t*)(ws + OFF_WT_O); p.wt_s = (bf16_t*)(ws + OFF_WT_S); p.membf = (bf16_t*)(ws + OFF_MEMBF); p.kmat = (bf16_t*)(ws + OFF_KV); p.vtm = (bf16_t*)(ws + OFF_KV + 9 * MB);
    p.pcs = (float*)(ws + OFF_SU); p.pbw = (float*)(ws + OFF_SV); p.cs = (float*)(ws + 65536); p.bw = (float*)(ws + 65536 + 32768);
    p.xres = (bf16_t*)(ws + OFF_XRES);
    p.xq = (unsigned char*)(ws + OFF_XQ); p.mixq = (unsigned char*)(ws + OFF_MIXQ); p.part = (float*)(ws + OFF_H + 160 * MB); p.yq = (unsigned char*)(ws + OFF_YQ); p.wq_s = (unsigned char*)(ws + OFF_WQS); p.sc_s = (float*)(ws + OFF_WQS + 16 * MB);
    p.wq_in0 = (unsigned char*)(ws + OFF_WQ); p.wq_in1 = p.wq_in0 + 4 * MB; p.wq_in2 = p.wq_in1 + 10 * MB; p.wq_in3 = p.wq_in2 + 4 * MB; p.wq_o = p.wq_in3 + 10 * MB;
    p.sc_in = (float*)(ws + OFF_WQ + 44 * MB); p.sc_o = (float*)(ws + OFF_WQ + 45 * MB);
    p.U8 = (unsigned char*)(ws + OFF_U); p.V8 = (unsigned char*)(ws + OFF_V); p.xbf = (bf16_t*)(ws + OFF_XBF); p.h = (bf16_t*)(ws + OFF_H); p.vtd = (bf16_t*)(ws + OFF_H + 224 * MB); p.mix = (bf16_t*)(ws + OFF_MIX);
    static int grid = 0;
    if (!grid) {
        int dev = 0, cus = 0, per_cu = 0;
        hipGetDevice(&dev);
        hipDeviceGetAttribute(&cus, hipDeviceAttributeMultiprocessorCount, dev);
        hipFuncSetAttribute((const void*)mega, hipFuncAttributeMaxDynamicSharedMemorySize, LDS_TOTAL);
        hipOccupancyMaxActiveBlocksPerMultiprocessor(&per_cu, mega, NTHR, LDS_TOTAL);
        grid = cus * (per_cu < 1 ? per_cu : 1);
    }
    if (grid <= 0) return;
    hipMemsetAsync(p.bar, 0, XCD_BAR_WORDS * sizeof(unsigned), stream);
    hipLaunchKernelGGL(mega, dim3(grid), dim3(NTHR), LDS_TOTAL, stream, p);
}
```
